# Optimizing an MI355X kernel written in HIP

```python
import jax, jax.numpy as jnp
from jax import lax
import numpy as np

D_MODEL = 1024
BATCH = 8
SEQ = 2048
DEPTH = 4
DEC_BATCH = 128
DEC_SEQ = 4
PAST_LEN = 8192
PAGE_SIZE = 128

D_PLE = 256
M_HEADS = 4
M_DQK = D_MODEL // 8
M_DV = D_MODEL // 4
M_CHUNK = 64
S_HEADS = 16
S_KV_HEADS = 4
S_HEAD_DIM = D_MODEL // S_HEADS
S_GROUP = S_HEADS // S_KV_HEADS
WINDOW = 128
REL_BUCKETS = 32
REL_MAX_DIST = WINDOW
N_GROUPS = 4
EXPERTS_PER_GROUP = 8
N_EXPERTS = N_GROUPS * EXPERTS_PER_GROUP
TOP_K = 2
D_EXPERT = D_MODEL // 2
MOE_BLOCK = 128
DN_ALPHA = (2 * DEPTH) ** 0.25
DN_BETA = (8 * DEPTH) ** -0.25
LN_EPS = 1e-5

_IN_SIZES = (
    M_HEADS * M_DQK,
    M_HEADS * M_DQK,
    M_HEADS * M_DV,
    M_HEADS * M_DV,
    M_HEADS,
    M_HEADS,
    S_HEADS * S_HEAD_DIM,
    S_KV_HEADS * S_HEAD_DIM,
    S_KV_HEADS * S_HEAD_DIM,
    D_MODEL,
    D_MODEL,
)
_IN_SPLITS = tuple(sum(_IN_SIZES[:j + 1]) for j in range(len(_IN_SIZES) - 1))
D_IN = sum(_IN_SIZES)
F_OFF = _IN_SPLITS[4]

kernel_name = 'hybrid_mlstm_swa_hmoe_decoder_step'


def layer_norm(x, g, b):
    xf = x.astype(jnp.float32)
    mu = xf.mean(-1, keepdims=True)
    var = jnp.square(xf - mu).mean(-1, keepdims=True)
    return ((xf - mu) * lax.rsqrt(var + LN_EPS) * g.astype(jnp.float32) + b.astype(jnp.float32)).astype(x.dtype)


def rel_bucket(dist):
    n = np.maximum(dist, 0)
    max_exact = REL_BUCKETS // 2
    large = max_exact + (np.log(np.maximum(n, 1) / max_exact) / np.log(REL_MAX_DIST / max_exact)
                         * (REL_BUCKETS - max_exact)).astype(np.int32)
    large = np.minimum(large, REL_BUCKETS - 1)
    return np.where(n < max_exact, n, large).astype(np.int32)


def rel_bias(rel_table, dist):
    bias = rel_table[rel_bucket(dist)].astype(jnp.float32)
    return jnp.transpose(bias, (2, 0, 1)).reshape((S_KV_HEADS, S_GROUP) + dist.shape)


def sink_softmax(s, sink):
    sk = sink.astype(jnp.float32)[:, :, None, None]
    m = jnp.maximum(s.max(-1, keepdims=True), sk)
    p = jnp.exp(s - m)
    return p / (p.sum(-1, keepdims=True) + jnp.exp(sk - m))


def swa_prompt(q, k, v, rel_table, sink):
    B, T = q.shape[:2]
    nb = T // WINDOW
    qb = q.reshape(B, nb, WINDOW, S_KV_HEADS, S_GROUP, S_HEAD_DIM)
    kb = k.reshape(B, nb, WINDOW, S_KV_HEADS, S_HEAD_DIM)
    vb = v.reshape(B, nb, WINDOW, S_KV_HEADS, S_HEAD_DIM)
    shift = ((0, 0), (1, 0), (0, 0), (0, 0), (0, 0))
    kk = jnp.concatenate([jnp.pad(kb, shift)[:, :-1], kb], axis=2)
    vv = jnp.concatenate([jnp.pad(vb, shift)[:, :-1], vb], axis=2)
    s = jnp.einsum('bnqhgd,bnkhd->bnhgqk', qb, kk).astype(jnp.float32) * (S_HEAD_DIM ** -0.5)
    qi = np.arange(WINDOW)[:, None]
    kj = np.arange(2 * WINDOW)[None, :]
    dist = qi + WINDOW - kj
    band = (dist >= 0) & (dist <= WINDOW)
    blk = np.arange(nb)[:, None, None]
    mask = band[None] & ((blk > 0) | (kj >= WINDOW)[None])
    s = jnp.where(mask[None, :, None, None], s + rel_bias(rel_table, dist), -jnp.inf)
    p = sink_softmax(s, sink.reshape(S_KV_HEADS, S_GROUP))
    o = jnp.einsum('bnhgqk,bnkhd->bnqhgd', p.astype(vv.dtype), vv)
    return o.reshape(B, T, S_HEADS * S_HEAD_DIM), k[:, -WINDOW:], v[:, -WINDOW:]


def swa_sample(q, k, v, buf_k, buf_v, rel_table, sink):
    B, T = q.shape[:2]
    kk = jnp.concatenate([buf_k.astype(k.dtype), k], axis=1)
    vv = jnp.concatenate([buf_v.astype(v.dtype), v], axis=1)
    qg = q.reshape(B, T, S_KV_HEADS, S_GROUP, S_HEAD_DIM)
    s = jnp.einsum('bqhgd,bkhd->bhgqk', qg, kk).astype(jnp.float32) * (S_HEAD_DIM ** -0.5)
    dist = np.arange(T)[:, None] + WINDOW - np.arange(WINDOW + T)[None, :]
    mask = (dist >= 0) & (dist <= WINDOW)
    s = jnp.where(mask, s + rel_bias(rel_table, dist), -jnp.inf)
    p = sink_softmax(s, sink.reshape(S_KV_HEADS, S_GROUP))
    o = jnp.einsum('bhgqk,bkhd->bqhgd', p.astype(vv.dtype), vv)
    return o.reshape(B, T, S_HEADS * S_HEAD_DIM), kk[:, -WINDOW:], vv[:, -WINDOW:]


def mlstm_mix(q, k, v, ig, fg, C0, n0, m0):
    B, T = q.shape[:2]
    L = M_CHUNK if T % M_CHUNK == 0 else T
    nc = T // L

    def to_chunks(a):
        a = a.reshape((B, nc, L) + a.shape[2:])
        return jnp.moveaxis(jnp.moveaxis(a, 1, 0), 2, 3)

    causal = np.tril(np.ones((L, L), dtype=bool))

    def step(carry, inp):
        C, n, m = carry
        qc, kc, vc, ic, lfc = inp
        b = jnp.cumsum(lfc, axis=-1)
        dmat = jnp.where(causal, b[..., :, None] - b[..., None, :] + ic[..., None, :], -jnp.inf)
        inter = b + m[..., None]
        mhat = jnp.maximum(inter, dmat.max(-1))
        w_intra = jnp.exp(dmat - mhat[..., None])
        w_inter = jnp.exp(inter - mhat)
        s = jnp.einsum('bhld,bhsd->bhls', qc, kc) * w_intra
        num = jnp.einsum('bhls,bhsv->bhlv', s, vc) + w_inter[..., None] * jnp.einsum('bhld,bhdv->bhlv', qc, C)
        den = s.sum(-1) + w_inter * jnp.einsum('bhld,bhd->bhl', qc, n)
        h = num / jnp.maximum(jnp.abs(den), jnp.exp(-mhat))[..., None]
        b_end = b[..., -1]
        g = ic + b_end[..., None] - b
        m_new = jnp.maximum(b_end + m, g.max(-1))
        decay = jnp.exp(b_end + m - m_new)
        kw = kc * jnp.exp(g - m_new[..., None])[..., None]
        C_new = decay[..., None, None] * C + jnp.einsum('bhld,bhlv->bhdv', kw, vc)
        n_new = decay[..., None] * n + kw.sum(2)
        return (C_new, n_new, m_new), h

    xs = (to_chunks(q), to_chunks(k), to_chunks(v), to_chunks(ig), to_chunks(jax.nn.log_sigmoid(fg)))
    (C, n, m), h = lax.scan(step, (C0, n0, m0), xs)
    h = jnp.moveaxis(jnp.moveaxis(h, 3, 2), 0, 1).reshape(B, T, M_HEADS, M_DV)
    return h, C, n, m


def routed_experts(xt, eid, tok, wt, w_gate, w_up, w_down):
    M, D = xt.shape
    A = eid.shape[0]
    nblk = -(-A // MOE_BLOCK) + N_EXPERTS
    P = nblk * MOE_BLOCK
    order = jnp.argsort(eid)
    eid_s, tok_s, wt_s = eid[order], tok[order], wt[order]
    counts = jnp.bincount(eid, length=N_EXPERTS)
    padded = (counts + MOE_BLOCK - 1) // MOE_BLOCK * MOE_BLOCK
    pad_end = jnp.cumsum(padded)
    pad_start = pad_end - padded
    start = jnp.cumsum(counts) - counts
    pos = pad_start[eid_s] + jnp.arange(A) - start[eid_s]
    row_tok = jnp.full((P,), M, jnp.int32).at[pos].set(tok_s)
    row_w = jnp.zeros((P,), jnp.float32).at[pos].set(wt_s)
    blk_e = jnp.minimum(jnp.searchsorted(pad_end, jnp.arange(nblk) * MOE_BLOCK, side='right'), N_EXPERTS - 1)
    x_pad = jnp.concatenate([xt, jnp.zeros((1, D), xt.dtype)], axis=0)
    xb = x_pad[row_tok].reshape(nblk, MOE_BLOCK, D)

    def expert_block(args):
        xblk, e = args
        h = jax.nn.silu(xblk @ w_gate[e]) * (xblk @ w_up[e])
        return h @ w_down[e]

    yb = lax.map(expert_block, (xb, blk_e))
    y = jnp.zeros((M + 1, D), jnp.float32).at[row_tok].add(yb.reshape(P, D).astype(jnp.float32) * row_w[:, None])
    return y[:M].astype(xt.dtype)


def hier_moe(x, w_rg, b_rg, w_re, b_re, w_eg, w_eu, w_ed):
    B, T, D = x.shape
    M = B * T
    xt = x.reshape(M, D)
    g_logits = (xt @ w_rg + b_rg).astype(jnp.float32)
    g_prob = jax.nn.softmax(g_logits, axis=-1)
    g_idx = jnp.argmax(g_logits, axis=-1)
    g_w = jnp.take_along_axis(g_prob, g_idx[:, None], axis=-1)
    e_logits = (xt @ w_re + b_re).astype(jnp.float32).reshape(M, N_GROUPS, EXPERTS_PER_GROUP)
    e_logits = jnp.take_along_axis(e_logits, g_idx[:, None, None], axis=1)[:, 0]
    top_p, top_i = lax.top_k(jax.nn.softmax(e_logits, axis=-1), TOP_K)
    gate = g_w * top_p / top_p.sum(-1, keepdims=True)
    eid = (g_idx[:, None] * EXPERTS_PER_GROUP + top_i).reshape(-1).astype(jnp.int32)
    tok = jnp.repeat(jnp.arange(M, dtype=jnp.int32), TOP_K)
    y = routed_experts(xt, eid, tok, gate.reshape(-1), w_eg, w_eu, w_ed)
    return y.reshape(B, T, D)


def layer(x, p_i, C0, n0, m0, buf_k, buf_v, w_in, b_in, mh_gain, w_a, w_b, w_out, rel_table, sink,
          ln_g, ln_b, w_rg, b_rg, w_re, b_re, w_eg, w_eu, w_ed, w_pg, w_pp):
    B, T, _ = x.shape
    f32 = jnp.float32
    z = x @ w_in + b_in
    qm, km, vm, og, ig, fg, qs, ks, vs, ga, gb = jnp.split(z, _IN_SPLITS, axis=-1)
    q = qm.reshape(B, T, M_HEADS, M_DQK).astype(f32) * (M_DQK ** -0.5)
    k = km.reshape(B, T, M_HEADS, M_DQK).astype(f32)
    v = vm.reshape(B, T, M_HEADS, M_DV).astype(f32)
    h, C, n, m = mlstm_mix(q, k, v, ig.astype(f32), fg.astype(f32), C0.astype(f32), n0.astype(f32), m0.astype(f32))
    mu = h.mean(-1, keepdims=True)
    var = jnp.square(h - mu).mean(-1, keepdims=True)
    h = (h - mu) * lax.rsqrt(var + LN_EPS) * mh_gain.reshape(M_HEADS, M_DV).astype(f32)
    ya = (h.reshape(B, T, M_HEADS * M_DV) * jax.nn.sigmoid(og.astype(f32))).astype(x.dtype)
    qs = qs.reshape(B, T, S_HEADS, S_HEAD_DIM)
    ks = ks.reshape(B, T, S_KV_HEADS, S_HEAD_DIM)
    vs = vs.reshape(B, T, S_KV_HEADS, S_HEAD_DIM)
    if buf_k is None:
        yb, kw, vw = swa_prompt(qs, ks, vs, rel_table, sink)
    else:
        yb, kw, vw = swa_sample(qs, ks, vs, buf_k, buf_v, rel_table, sink)
    mix = (jax.nn.sigmoid(ga) * (ya @ w_a) + jax.nn.sigmoid(gb) * (yb @ w_b)) @ w_out
    x = layer_norm(DN_ALPHA * x + mix, ln_g[0], ln_b[0])
    x = layer_norm(DN_ALPHA * x + hier_moe(x, w_rg, b_rg, w_re, b_re, w_eg, w_eu, w_ed), ln_g[1], ln_b[1])
    ple = jax.nn.sigmoid(x @ w_pg) * (p_i @ w_pp)
    x = layer_norm(DN_ALPHA * x + ple, ln_g[2], ln_b[2])
    return x, (C, n, m, kw, vw)


def setup_inputs(seed: int = 0) -> dict:
    key = jax.random.key(seed)
    ks = jax.random.split(key, 32)
    f32 = jnp.float32

    def nrm(k, shape, scale):
        return jax.random.normal(k, shape, f32) * scale

    b_in = nrm(ks[10], (DEPTH, D_IN), 0.01)
    b_in = b_in.at[:, F_OFF:F_OFF + M_HEADS].add(jnp.linspace(3.0, 6.0, M_HEADS))
    return {
        'x_prompt': nrm(ks[0], (BATCH, SEQ, D_MODEL), 1.0),
        'x_sample': nrm(ks[1], (DEC_BATCH, DEC_SEQ, D_MODEL), 1.0),
        'state_mlstm_C': nrm(ks[2], (DEPTH, DEC_BATCH, M_HEADS, M_DQK, M_DV), 0.5),
        'state_mlstm_n': nrm(ks[3], (DEPTH, DEC_BATCH, M_HEADS, M_DQK), 0.5),
        'state_mlstm_m': nrm(ks[4], (DEPTH, DEC_BATCH, M_HEADS), 1.0),
        'state_swa_k': nrm(ks[5], (DEPTH, DEC_BATCH, WINDOW, S_KV_HEADS, S_HEAD_DIM), 1.0),
        'state_swa_v': nrm(ks[6], (DEPTH, DEC_BATCH, WINDOW, S_KV_HEADS, S_HEAD_DIM), 1.0),
        'p_prompt': nrm(ks[7], (DEPTH, BATCH, SEQ, D_PLE), 1.0),
        'p_sample': nrm(ks[8], (DEPTH, DEC_BATCH, DEC_SEQ, D_PLE), 1.0),
        'w_in': nrm(ks[9], (DEPTH, D_MODEL, D_IN), D_MODEL ** -0.5),
        'b_in': b_in,
        'mh_gain': 1.0 + nrm(ks[11], (DEPTH, M_HEADS * M_DV), 0.02),
        'w_a': nrm(ks[12], (DEPTH, M_HEADS * M_DV, D_MODEL), (M_HEADS * M_DV) ** -0.5),
        'w_b': nrm(ks[13], (DEPTH, S_HEADS * S_HEAD_DIM, D_MODEL), (S_HEADS * S_HEAD_DIM) ** -0.5),
        'w_out': nrm(ks[14], (DEPTH, D_MODEL, D_MODEL), D_MODEL ** -0.5 * DN_BETA),
        'rel_table': nrm(ks[15], (REL_BUCKETS, S_HEADS), 0.5),
        'w_sink': nrm(ks[16], (DEPTH, S_HEADS), 0.5),
        'ln_g': 1.0 + nrm(ks[17], (DEPTH, 3, D_MODEL), 0.02),
        'ln_b': nrm(ks[18], (DEPTH, 3, D_MODEL), 0.01),
        'w_rg': nrm(ks[19], (DEPTH, D_MODEL, N_GROUPS), D_MODEL ** -0.5),
        'b_rg': nrm(ks[20], (DEPTH, N_GROUPS), 0.01),
        'w_re': nrm(ks[21], (DEPTH, D_MODEL, N_EXPERTS), D_MODEL ** -0.5),
        'b_re': nrm(ks[22], (DEPTH, N_EXPERTS), 0.01),
        'w_eg': nrm(ks[23], (DEPTH, N_EXPERTS, D_MODEL, D_EXPERT), D_MODEL ** -0.5 * DN_BETA),
        'w_eu': nrm(ks[24], (DEPTH, N_EXPERTS, D_MODEL, D_EXPERT), D_MODEL ** -0.5 * DN_BETA),
        'w_ed': nrm(ks[25], (DEPTH, N_EXPERTS, D_EXPERT, D_MODEL), D_EXPERT ** -0.5 * DN_BETA),
        'w_pg': nrm(ks[26], (DEPTH, D_MODEL, D_MODEL), D_MODEL ** -0.5),
        'w_pp': nrm(ks[27], (DEPTH, D_PLE, D_MODEL), D_PLE ** -0.5 * DN_BETA),
    }


def reference(x_prompt, x_sample, state_mlstm_C, state_mlstm_n, state_mlstm_m, state_swa_k, state_swa_v,
              p_prompt, p_sample, w_in, b_in, mh_gain, w_a, w_b, w_out, rel_table, w_sink, ln_g, ln_b,
              w_rg, b_rg, w_re, b_re, w_eg, w_eu, w_ed, w_pg, w_pp):
    bp = x_prompt.shape[0]
    zC = jnp.zeros((bp, M_HEADS, M_DQK, M_DV), jnp.float32)
    zn = jnp.zeros((bp, M_HEADS, M_DQK), jnp.float32)
    zm = jnp.zeros((bp, M_HEADS), jnp.float32)
    xp, xs = x_prompt, x_sample
    new_p, new_s = [], []
    for i in range(DEPTH):
        wts = (w_in[i], b_in[i], mh_gain[i], w_a[i], w_b[i], w_out[i], rel_table, w_sink[i], ln_g[i], ln_b[i],
               w_rg[i], b_rg[i], w_re[i], b_re[i], w_eg[i], w_eu[i], w_ed[i], w_pg[i], w_pp[i])
        xp, sp = layer(xp, p_prompt[i], zC, zn, zm, None, None, *wts)
        xs, ss = layer(xs, p_sample[i], state_mlstm_C[i], state_mlstm_n[i], state_mlstm_m[i],
                       state_swa_k[i], state_swa_v[i], *wts)
        new_p.append(sp)
        new_s.append(ss)

    def stk(lst, j):
        return jnp.stack([s[j] for s in lst], axis=0)

    return (xp, xs,
            stk(new_p, 0), stk(new_p, 1), stk(new_p, 2), stk(new_p, 3), stk(new_p, 4),
            stk(new_s, 0), stk(new_s, 1), stk(new_s, 2), stk(new_s, 3), stk(new_s, 4))
```

```cpp
#include <hip/hip_runtime.h>
#include <cstdio>
#include <cstdint>

#ifndef REP_SEL
#define REP_SEL -1
#define REP_N 1
#endif
#ifndef MK_ONE_LAUNCH
#define MK_ONE_LAUNCH 1
#endif

#define LAS __attribute__((address_space(3)))
#define GAS __attribute__((address_space(1)))
typedef unsigned short bf16;
typedef short bf16x8 __attribute__((ext_vector_type(8)));
typedef short bf16x4 __attribute__((ext_vector_type(4)));
typedef float f32x4 __attribute__((ext_vector_type(4)));
typedef float f32x2 __attribute__((ext_vector_type(2)));
typedef unsigned u32x4 __attribute__((ext_vector_type(4)));
typedef unsigned u32x2 __attribute__((ext_vector_type(2)));

constexpr int D = 1024, TP = 16384, TS = 512, T = TP + TS, DEPTH = 4, SEQ = 2048;
constexpr int DIN = 6664, NIN = 6656;
constexpr int NEXP = 32, DEXP = 512, DPLE = 256;
constexpr int ECAP = 2048, PMAX = NEXP * ECAP;
constexpr float LN_EPS = 1e-5f;
constexpr float DN_ALPHA = 1.6817928305074292f;
constexpr int NW = 8, NT = 512;

constexpr size_t O_Y = 0, O_CP = 17301504, O_NP = 21495808, O_MP = 21512192, O_KP = 21512320, O_VP = 22560896,
                 O_CS = 23609472, O_NS = 90718336, O_MS = 90980480, O_KS = 90982528, O_VS = 107759744, O_END = 124536960;

constexpr size_t al256(size_t x) { return (x + 255) & ~(size_t)255; }
constexpr size_t WS_CTL = 0, CTL_BYTES = 1u << 20;
constexpr size_t WS_WIN = CTL_BYTES;
constexpr size_t WS_WA = WS_WIN + (size_t)NIN * D * 2;
constexpr size_t WS_WB = WS_WA + (size_t)D * D * 2;
constexpr size_t WS_WOUT = WS_WB + (size_t)D * D * 2;
constexpr size_t WS_WPG = WS_WOUT + (size_t)D * D * 2;
constexpr size_t WS_WPP = WS_WPG + (size_t)D * D * 2;
constexpr size_t WS_WGU = WS_WPP + (size_t)D * DPLE * 2;
constexpr size_t WS_WD = WS_WGU + (size_t)NEXP * D * D * 2;
constexpr size_t WS_X = WS_WD + (size_t)NEXP * D * DEXP * 2;
constexpr size_t WS_XB = WS_X + (size_t)T * D * 4;
constexpr size_t WS_QM = WS_XB + (size_t)T * D * 2;
constexpr size_t WS_KM = WS_QM + (size_t)T * 512 * 2;
constexpr size_t WS_VM = WS_KM + (size_t)T * 512 * 2;
constexpr size_t WS_OG = WS_VM + (size_t)T * D * 2;
constexpr size_t WS_QS = WS_OG + (size_t)T * D * 2;
constexpr size_t WS_KS = WS_QS + (size_t)T * D * 2;
constexpr size_t WS_VS = WS_KS + (size_t)T * 256 * 2;
constexpr size_t WS_GA = WS_VS + (size_t)T * 256 * 2;
constexpr size_t WS_GB = WS_GA + (size_t)T * D * 2;
constexpr size_t WS_IGFG = WS_GB + (size_t)T * D * 2;
constexpr size_t WS_YA = al256(WS_IGFG + (size_t)T * 8 * 4);
constexpr size_t WS_YB = WS_YA + (size_t)T * D * 2;
constexpr size_t WS_MIXA = WS_YB + (size_t)T * D * 2;
constexpr size_t WS_U = WS_MIXA + (size_t)T * D * 4;
constexpr size_t WS_XG = WS_U + (size_t)T * D * 2;
constexpr size_t WS_H = WS_XG + (size_t)PMAX * D * 2;
constexpr size_t WS_YS = WS_H + (size_t)PMAX * DEXP * 2;
constexpr size_t WS_PB = WS_YS + (size_t)PMAX * D * 2;
constexpr size_t WS_T2 = WS_PB + (size_t)T * DPLE * 2;
constexpr size_t WS_CC = WS_T2 + (size_t)T * D * 2;
constexpr size_t WS_ASG = WS_CC + (size_t)1024 * 32768 * 2;
constexpr size_t WS_GATE = WS_ASG + (size_t)T * 2 * 4;
constexpr size_t WS_SLOT = WS_GATE + (size_t)T * 2 * 4;
constexpr size_t WS_BEND = WS_SLOT + (size_t)T * 2 * 4;
constexpr size_t WS_GMX = WS_BEND + 4096;
constexpr size_t WS_MC = WS_GMX + 4096;
constexpr size_t WS_DN = WS_MC + 4096;
constexpr size_t WS_NC = WS_DN + (size_t)1024 * 128 * 4;
constexpr size_t WS_W2 = al256(WS_NC + (size_t)1024 * 128 * 4);
constexpr size_t WSET_SHIFT = WS_W2 - WS_WIN;
constexpr size_t WS_RW = al256(WS_W2 + (WS_X - WS_WIN));
constexpr size_t WS_LG = al256(WS_RW + 149504);
constexpr size_t WS_END = WS_LG + (size_t)T * 48 * 4;

constexpr int CW_BAR = 4096;
constexpr int CW_CNT = 16384;

constexpr int LDS_BYTES = 157696;
constexpr int LDSCTL_OFF = 153600;
constexpr int LW_CNT = 0, LW_BASE = 32, LW_FCNT = 64, LW_PST = 96, LW_NP = 129, LW_OVF = 130, LW_XB = 132, LW_PANE = 160;

__device__ __forceinline__ unsigned f2bf(float f) { unsigned u = __float_as_uint(f); return (u + 0x7fffu + ((u >> 16) & 1u)) >> 16; }
__device__ __forceinline__ float bf2f(unsigned b) { return __uint_as_float(b << 16); }
__device__ __forceinline__ float bflo(unsigned w) { return __uint_as_float(w << 16); }
__device__ __forceinline__ float bfhi(unsigned w) { return __uint_as_float(w & 0xffff0000u); }
__device__ __forceinline__ unsigned pk2(float lo, float hi) { unsigned r; asm volatile("v_cvt_pk_bf16_f32 %0, %1, %2" : "=v"(r) : "v"(lo), "v"(hi)); return r; }
template <int CTRL, int ROWMASK> __device__ __forceinline__ float dppf(float v) { return __builtin_bit_cast(float, __builtin_amdgcn_update_dpp(0, __builtin_bit_cast(int, v), CTRL, ROWMASK, 0xf, false)); }
__device__ __forceinline__ float dpp_sum63(float v) {
    v += dppf<0xB1, 0xf>(v); v += dppf<0x4E, 0xf>(v); v += dppf<0x141, 0xf>(v); v += dppf<0x140, 0xf>(v);
    v += dppf<0x142, 0xa>(v); v += dppf<0x143, 0xc>(v); return v;
}
template <int CTRL, int ROWMASK> __device__ __forceinline__ float dppm(float v) { return __builtin_bit_cast(float, __builtin_amdgcn_update_dpp(__builtin_bit_cast(int, v), __builtin_bit_cast(int, v), CTRL, ROWMASK, 0xf, false)); }
__device__ __forceinline__ float rdlane(float v, int l) { return __builtin_bit_cast(float, __builtin_amdgcn_readlane(__builtin_bit_cast(int, v), l)); }
__device__ __forceinline__ float wave_sum(float v) { return rdlane(dpp_sum63(v), 63); }
__device__ __forceinline__ float wave_max(float v) {
    v = fmaxf(v, dppm<0xB1, 0xf>(v)); v = fmaxf(v, dppm<0x4E, 0xf>(v)); v = fmaxf(v, dppm<0x141, 0xf>(v)); v = fmaxf(v, dppm<0x140, 0xf>(v));
    v = fmaxf(v, dppm<0x142, 0xa>(v)); v = fmaxf(v, dppm<0x143, 0xc>(v)); return rdlane(v, 63);
}
__device__ __forceinline__ float bperm(float v, int srclane) { return __builtin_bit_cast(float, __builtin_amdgcn_ds_bpermute(srclane << 2, __builtin_bit_cast(int, v))); }
constexpr float LOG2E = 1.4426950408889634f;
__device__ __forceinline__ float sigmoid_fast(float x) { return __builtin_amdgcn_rcpf(1.0f + __expf(-x)); }
__device__ __forceinline__ float log_sigmoid(float x) { return fminf(x, 0.f) - log1pf(expf(-fabsf(x))); }
typedef short s16x4 __attribute__((ext_vector_type(4)));
__device__ __forceinline__ s16x4 tr_rd(unsigned a) { return __builtin_amdgcn_ds_read_tr16_b64_v4i16((LAS s16x4*)(__UINTPTR_TYPE__)a); }
__device__ __forceinline__ bf16x8 tr_frag(unsigned a0, unsigned a1) { const s16x4 r0 = tr_rd(a0), r1 = tr_rd(a1); return (bf16x8){r0[0], r0[1], r0[2], r0[3], r1[0], r1[1], r1[2], r1[3]}; }
__device__ __forceinline__ void tr_frag4(unsigned a0, unsigned a1, unsigned step, bf16x8 (&f)[4]) {
#pragma unroll
    for (int i = 0; i < 4; ++i) f[i] = tr_frag(a0 + i * step, a1 + i * step); }
__device__ __forceinline__ unsigned lds_addr(LAS void* p) { return (unsigned)(__UINTPTR_TYPE__)p; }
#define LDS_WAIT() asm volatile("s_waitcnt lgkmcnt(0)" ::: "memory")
#define VM_WAIT() asm volatile("s_waitcnt vmcnt(0)" ::: "memory")

__device__ const unsigned char RELB[132] = {0, 1, 2, 3, 4, 5, 6, 7, 8, 9, 10, 11, 12, 13, 14, 15, 16, 16, 16, 17, 17, 18, 18, 18, 19, 19, 19, 20, 20, 20, 20, 21, 21, 21, 21, 22, 22, 22, 22, 22, 23, 23, 23, 23, 23, 23, 24, 24, 24, 24, 24, 24, 25, 25, 25, 25, 25, 25, 25, 26, 26, 26, 26, 26, 26, 26, 26, 27, 27, 27, 27, 27, 27, 27, 27, 27, 27, 28, 28, 28, 28, 28, 28, 28, 28, 28, 28, 29, 29, 29, 29, 29, 29, 29, 29, 29, 29, 29, 29, 30, 30, 30, 30, 30, 30, 30, 30, 30, 30, 30, 30, 30, 30, 31, 31, 31, 31, 31, 31, 31, 31, 31, 31, 31, 31, 31, 31, 31, 31, 31, 31, 31};

#define XB_TMO      128
#define XB_XCNT(j)  (256  + 64 * (j))
#define XB_XSUB(j)  (1280 + 64 * (j))
#define XB_XGEN(j)  (2304 + 64 * (j))
#define XB_TOP      3328
#define XB_TOPGEN   3392
#define XCD_BAR_WORDS 3456
#define XB_SPIN_CAP (1u << 18)
__device__ __forceinline__ unsigned xb_ld(unsigned* p)              { return __hip_atomic_load(p, __ATOMIC_RELAXED, __HIP_MEMORY_SCOPE_AGENT); }
__device__ __forceinline__ unsigned xb_add(unsigned* p, unsigned v) { return __hip_atomic_fetch_add(p, v, __ATOMIC_RELAXED, __HIP_MEMORY_SCOPE_AGENT); }
__device__ __forceinline__ unsigned xb_xcc_id() { return (unsigned)__builtin_amdgcn_s_getreg((3 << 11) | 20) & 0xFu; }
#define XB_SPIN(cond, bar) do { unsigned _sp = 0; while (cond) { __builtin_amdgcn_s_sleep(1); \
    if ((++_sp & 255u) == 0u) { if (xb_ld(&(bar)[XB_TMO])) break; if (_sp > XB_SPIN_CAP) { atomicAdd(&(bar)[XB_TMO], 1u); break; } } } } while (0)
struct XcdBarrier { unsigned* bar; unsigned x; volatile LAS unsigned* st; };
__device__ __forceinline__ XcdBarrier xcd_barrier_post(unsigned* bar, volatile LAS unsigned* st) {
    XcdBarrier b; b.bar = bar; b.x = xb_xcc_id(); b.st = st;
    if (threadIdx.x == 0) (void)xb_add(&bar[XB_XCNT(b.x)], 1u);
    return b;
}
__device__ __forceinline__ void xcd_barrier_complete(unsigned* bar, unsigned x, unsigned& nloc, unsigned& nx) {
    const unsigned G = gridDim.x * gridDim.y * gridDim.z;
    unsigned sum, cnt, mine, sp = 0u;
    for (;;) {
        sum = 0u; cnt = 0u; mine = 0u;
#pragma unroll
        for (unsigned j = 0; j < 16; ++j) { const unsigned c = xb_ld(&bar[XB_XCNT(j)]); sum += c; cnt += (c > 0u) ? 1u : 0u; mine = (j == x) ? c : mine; }
        if (sum == G) break;
        __builtin_amdgcn_s_sleep(1);
        if ((++sp & 255u) == 0u) { if (xb_ld(&bar[XB_TMO])) break; if (sp > XB_SPIN_CAP) { atomicAdd(&bar[XB_TMO], 1u); break; } }
    }
    nloc = mine > 0u ? mine : 1u; nx = cnt > 0u ? cnt : 1u;
}
__device__ __forceinline__ void xcd_barrier(const XcdBarrier& b) {
    asm volatile("s_waitcnt vmcnt(0)" ::: "memory");
    __syncthreads();
    if (threadIdx.x == 0) {
        unsigned* bar = b.bar;
        __builtin_amdgcn_s_waitcnt(0);
        unsigned nloc = b.st[0], nx = b.st[1];
        if (nloc == 0u) { xcd_barrier_complete(bar, b.x, nloc, nx); b.st[0] = nloc; b.st[1] = nx; }
        const unsigned old = xb_add(&bar[XB_XSUB(b.x)], 1u);
        const unsigned gen = old / nloc;
        if (old + 1u == (gen + 1u) * nloc) {
            __builtin_amdgcn_fence(__ATOMIC_RELEASE, "agent");
            asm volatile("s_waitcnt vmcnt(0)" ::: "memory");
            const unsigned og = xb_add(&bar[XB_TOP], 1u);
            const unsigned tg = og / nx;
            if (og + 1u == (tg + 1u) * nx) xb_add(&bar[XB_TOPGEN], 1u);
            else XB_SPIN(xb_ld(&bar[XB_TOPGEN]) == tg, bar);
            __builtin_amdgcn_fence(__ATOMIC_ACQUIRE, "agent");
            xb_add(&bar[XB_XGEN(b.x)], 1u);
            asm volatile("s_waitcnt vmcnt(0)" ::: "memory");
        } else {
            XB_SPIN(xb_ld(&bar[XB_XGEN(b.x)]) == gen, bar);
            __builtin_amdgcn_fence(__ATOMIC_ACQUIRE, "agent");
            asm volatile("s_waitcnt vmcnt(0)" ::: "memory");
        }
    }
    __syncthreads();
}

#ifndef PANE_EXPR
#define PANE_EXPR __builtin_amdgcn_readfirstlane(pane[u.pm])
#endif
namespace pg8 {
constexpr int BM = 256, BK = 64, HALF = 128, HTB = HALF * BK * 2, STAGE_BYTES = 8 * HTB, NXCD = 8, WGM = 8;
__host__ __device__ __forceinline__ int lds_byte(int r, int c) { const int st = (r >> 4) * 2 + (c >> 5), rr = r & 15, cc = c & 31, ob = rr * 64 + cc * 2; return st * 1024 + (ob ^ (((ob >> 9) & 1) << 5)); }
__host__ __device__ __forceinline__ void stage_rc(int b, int& R, int& C) { const int st = b / 1024, sb = b % 1024, swz = sb ^ (((sb >> 9) & 1) << 5); R = (st >> 1) * 16 + swz / 64; C = (st & 1) * 32 + (swz % 64) / 2; }
__host__ __device__ __forceinline__ int perm32(int rho) { const int n = rho >> 4, i = rho & 15; return 8 * (i >> 2) + 4 * n + (i & 3); }

struct Unit { int pm, pn, pb, sel; };

struct StaticOrder {
    int nM, nN, nwg, G, c;
    __device__ void init(int nM_, int nN_, int G_, int c_) { nM = nM_; nN = nN_; nwg = nM * nN; G = G_; c = c_; }
    __device__ bool next(int i, Unit& u) const {
        const long L = (long)i * G + c; if (L >= nwg) return false;
        int wgid = (int)L; { const int q = nwg / NXCD, r = nwg % NXCD, xcd = wgid % NXCD, off = wgid / NXCD; wgid = (xcd < r ? xcd * (q + 1) : r * (q + 1) + (xcd - r) * q) + off; }
        const int nig = WGM * nN, gid = wgid / nig, fm = gid * WGM, gsz = (nM - fm) < WGM ? (nM - fm) : WGM;
        u.pm = fm + ((wgid % nig) % gsz); u.pn = (wgid % nig) / gsz; u.pb = u.pn; u.sel = 0; return true;
    }
};
struct PairOrder {
    StaticOrder so;
    __device__ bool next(int i, Unit& u) const { if (!so.next(i >> 1, u)) return false; u.sel = i & 1; return true; }
};
struct SubsetOrder {
    int nu, nw, r;
    __device__ bool next(int i, Unit& u) const { const int L = i * nw + r; if (L >= nu) return false; u.pm = L >> 2; u.pn = L & 3; u.pb = u.pn; u.sel = 0; return true; }
};
struct MoeOrder {
    const volatile LAS int* pane; int np, G, c;
    __device__ bool next(int i, Unit& u) const {
        const int L = i * G + c; if (L >= np * 4) return false;
        const int v = __builtin_amdgcn_readfirstlane(pane[L >> 2]); u.pm = v & 0xffff; u.pn = L & 3; u.pb = (v >> 16) * 4 + u.pn; u.sel = 0; return true;
    }
};

template <class Epi, class Sched>
__device__ __forceinline__ void gemm_phase(const int tid, LAS unsigned char* lds, const bf16* Aop, const bf16* Bop, const int K_, const Sched& S, const Epi& E, const bf16* Aop1 = nullptr, const bf16* Bop1 = nullptr) {
    int K = K_; asm volatile("" : "+s"(K));
    const int wid = __builtin_amdgcn_readfirstlane(tid >> 6), lane = tid & 63, wr = wid >> 2, wc = wid & 3, fr = lane & 15, fq = lane >> 4;
    const int nt = K / BK;
    unsigned voffA[2], voffB[2];
#pragma unroll
    for (int i = 0; i < 2; ++i) { int R, C; stage_rc(tid * 16 + i * 8192, R, C); const int Rb = Epi::PERM ? ((R & ~31) + perm32(R & 31)) : R;
        voffA[i] = (unsigned)(R * K + C) * 2u; voffB[i] = (unsigned)(Rb * K + C) * 2u; }
    const size_t kstep = (size_t)(BK * 2);
    const size_t hstep = (size_t)HALF * K * 2;
    const size_t tstep = 2 * hstep;
    const unsigned ldsw = (unsigned)wid * 1024u;
    const int aoff = lds_byte(wr * 64 + fr, fq * 8), boff = lds_byte(wc * 32 + fr, fq * 8);
#define PG8_SA(b, h) (((b) * 2 + (h)) * HTB)
#define PG8_SB(b, h) ((4 + (b) * 2 + (h)) * HTB)
#define PG8_STAGE(bufoff, gbase, voff) do { _Pragma("unroll") for (int _i = 0; _i < 2; ++_i) \
        __builtin_amdgcn_global_load_lds((const unsigned*)((const char*)(gbase) + (voff)[_i]), (LAS unsigned*)(lds + (bufoff) + ldsw + _i * 8192), 16, 0, 0); } while (0)
#define PG8_LDA(dst, b, h) do { _Pragma("unroll") for (int m = 0; m < 4; ++m) _Pragma("unroll") for (int k = 0; k < 2; ++k) dst[m][k] = *(const LAS bf16x8*)(lds + PG8_SA(b, h) + aoff + m * 2048 + k * 1024); } while (0)
#define PG8_LDB(dst, b, h) do { _Pragma("unroll") for (int n = 0; n < 2; ++n) _Pragma("unroll") for (int k = 0; k < 2; ++k) dst[n][k] = *(const LAS bf16x8*)(lds + PG8_SB(b, h) + boff + n * 2048 + k * 1024); } while (0)
#define PG8_MMA(ai, bj, At, Bt) do { __builtin_amdgcn_s_setprio(1); _Pragma("unroll") for (int m = 0; m < 4; ++m) _Pragma("unroll") for (int n = 0; n < 2; ++n) _Pragma("unroll") for (int k = 0; k < 2; ++k) \
        acc[ai][bj][m][n] = __builtin_amdgcn_mfma_f32_16x16x32_bf16(Bt[n][k], At[m][k], acc[ai][bj][m][n], 0, 0, 0); __builtin_amdgcn_s_setprio(0); } while (0)
#define PG8_WAIT_V(n) asm volatile("s_waitcnt vmcnt(" #n ")" ::: "memory")
#define PG8_WAIT_L(n) asm volatile("s_waitcnt lgkmcnt(" #n ")" ::: "memory")
#define PG8_BAR __builtin_amdgcn_s_barrier()
#define PG8_SCHED __builtin_amdgcn_sched_barrier(0)
    Unit cur, nxt; int ui = 0;
    if (!S.next(0, cur)) return;
    f32x4 acc[2][2][4][2];
#pragma unroll
    for (int a = 0; a < 2; ++a)
#pragma unroll
        for (int b = 0; b < 2; ++b)
#pragma unroll
            for (int m = 0; m < 4; ++m)
#pragma unroll
                for (int n = 0; n < 2; ++n) acc[a][b][m][n] = (f32x4){0.f, 0.f, 0.f, 0.f};
    bf16x8 At[4][2], B0[2][2], B1[2][2];
    const char* cA = (const char*)((Aop1 && cur.sel) ? Aop1 : Aop) + (size_t)cur.pm * tstep; const char* cB = (const char*)((Bop1 && cur.sel) ? Bop1 : Bop) + (size_t)cur.pb * tstep;
    PG8_STAGE(PG8_SB(0, 0), cB, voffB); PG8_STAGE(PG8_SB(0, 1), cB + hstep, voffB); PG8_STAGE(PG8_SA(0, 0), cA, voffA); PG8_STAGE(PG8_SA(0, 1), cA + hstep, voffA);
    if (wr == 1) PG8_BAR;
    PG8_WAIT_V(2); PG8_BAR;
    PG8_STAGE(PG8_SB(1, 0), cB + kstep, voffB); PG8_STAGE(PG8_SA(1, 0), cA + kstep, voffA); PG8_STAGE(PG8_SB(1, 1), cB + hstep + kstep, voffB);
    PG8_WAIT_V(6); PG8_BAR;
    for (;;) {
        const bool has_next = S.next(ui + 1, nxt);
        const char* nA = has_next ? (const char*)((Aop1 && nxt.sel) ? Aop1 : Aop) + (size_t)nxt.pm * tstep : cA; const char* nB = has_next ? (const char*)((Bop1 && nxt.sel) ? Bop1 : Bop) + (size_t)nxt.pb * tstep : cB;
        for (int t = 0; t < nt; t += 2) {
            const bool last = (t == nt - 2);
            const char* a1 = cA + (size_t)(t + 1) * kstep;
            const char* a2 = last ? nA : cA + (size_t)(t + 2) * kstep; const char* b2 = last ? nB : cB + (size_t)(t + 2) * kstep;
            const char* a3 = a2 + kstep; const char* b3 = b2 + kstep;
            PG8_LDB(B0, 0, 0); PG8_LDB(B1, 0, 1); PG8_SCHED; PG8_LDA(At, 0, 0); PG8_STAGE(PG8_SA(1, 1), a1 + hstep, voffA);
            PG8_WAIT_V(8); PG8_WAIT_L(0); PG8_BAR; PG8_MMA(0, 0, At, B0); PG8_MMA(0, 1, At, B1); PG8_BAR; PG8_SCHED;
            PG8_LDA(At, 0, 1); PG8_STAGE(PG8_SB(0, 0), b2, voffB); PG8_STAGE(PG8_SB(0, 1), b2 + hstep, voffB); PG8_STAGE(PG8_SA(0, 0), a2, voffA);
            PG8_WAIT_V(8); PG8_WAIT_L(0); PG8_BAR; PG8_MMA(1, 0, At, B0); PG8_MMA(1, 1, At, B1); PG8_BAR; PG8_SCHED;
            PG8_LDB(B0, 1, 0); PG8_LDB(B1, 1, 1); PG8_SCHED; PG8_LDA(At, 1, 0); PG8_STAGE(PG8_SA(0, 1), a2 + hstep, voffA);
            PG8_WAIT_V(8); PG8_WAIT_L(0); PG8_BAR; PG8_MMA(0, 0, At, B0); PG8_MMA(0, 1, At, B1); PG8_BAR; PG8_SCHED;
            PG8_LDA(At, 1, 1); PG8_STAGE(PG8_SB(1, 0), b3, voffB); PG8_STAGE(PG8_SB(1, 1), b3 + hstep, voffB); PG8_STAGE(PG8_SA(1, 0), a3, voffA);
            PG8_WAIT_V(8); PG8_WAIT_L(0); PG8_BAR; PG8_MMA(1, 0, At, B0); PG8_MMA(1, 1, At, B1); PG8_BAR; PG8_SCHED;
        }
        if (wr == 0) PG8_BAR;
        E(acc, cur, wr, wc, fr, fq);
        if (!has_next) break;
#pragma unroll
        for (int a = 0; a < 2; ++a)
#pragma unroll
            for (int b = 0; b < 2; ++b)
#pragma unroll
                for (int m = 0; m < 4; ++m)
#pragma unroll
                    for (int n = 0; n < 2; ++n) acc[a][b][m][n] = (f32x4){0.f, 0.f, 0.f, 0.f};
        cur = nxt; cA = nA; cB = nB; ++ui;
        if (wr == 1) PG8_BAR;
    }
    PG8_WAIT_V(0);
    PG8_BAR;
#undef PG8_SA
#undef PG8_SB
#undef PG8_STAGE
#undef PG8_LDA
#undef PG8_LDB
#undef PG8_MMA
#undef PG8_WAIT_V
#undef PG8_WAIT_L
#undef PG8_BAR
#undef PG8_SCHED
}
}

using pg8::Unit;
struct EpiIn {
    static constexpr bool PERM = true;
    unsigned char* ws; float* out; const float* bias; int L;
    __device__ __forceinline__ void operator()(const f32x4 (&acc)[2][2][4][2], const Unit& u, int wr, int wc, int fr, int fq) const {
        const int pn = u.pn; size_t boff; int ld, ct; float sc = 1.f; int act = 0, st = 0;
        if (pn < 2) { boff = WS_QM; ld = 512; ct = pn * 256; sc = 0.08838834764831845f; }
        else if (pn < 4) { boff = WS_KM; ld = 512; ct = (pn - 2) * 256; }
        else if (pn < 8) { boff = WS_VM; ld = 1024; ct = (pn - 4) * 256; }
        else if (pn < 12) { boff = WS_OG; ld = 1024; ct = (pn - 8) * 256; act = 1; }
        else if (pn < 16) { boff = WS_QS; ld = 1024; ct = (pn - 12) * 256; sc = 0.125f; }
        else if (pn == 16) { boff = WS_KS; ld = 256; ct = 0; st = 1; }
        else if (pn == 17) { boff = WS_VS; ld = 256; ct = 0; st = 2; }
        else if (pn < 22) { boff = WS_GA; ld = 1024; ct = (pn - 18) * 256; act = 1; }
        else { boff = WS_GB; ld = 1024; ct = (pn - 22) * 256; act = 1; }
        bf16* base = (bf16*)(ws + boff);
        float* so_p = out + (st == 1 ? O_KP : O_VP) + (size_t)L * 8 * 32768; float* so_s = out + (st == 1 ? O_KS : O_VS) + (size_t)L * 128 * 32768;
        const int cl = wc * 32 + 8 * fq;
        const int bcol0 = pn * 256 + cl + (pn < 12 ? 0 : 8);
        f32x4 bv[2][2];
#pragma unroll
        for (int bj = 0; bj < 2; ++bj)
#pragma unroll
            for (int n = 0; n < 2; ++n) bv[bj][n] = *(const f32x4*)(bias + bcol0 + bj * 128 + 4 * n);
#pragma unroll
        for (int ai = 0; ai < 2; ++ai)
#pragma unroll
            for (int m = 0; m < 4; ++m) {
                const int rloc = ai * 128 + wr * 64 + m * 16 + fr; const size_t row = (size_t)u.pm * 256 + rloc;
                bf16* rowp = base + row * ld + ct + cl;
                float* sp = nullptr;
                if (st) {
                    if (u.pm >= 64) { const int rs = (u.pm - 64) * 256 + rloc; sp = so_s + ((size_t)(rs >> 2) * 128 + 124 + (rs & 3)) * 256 + cl; }
                    else if ((u.pm & 7) == 7 && ai == 1) { sp = so_p + ((size_t)(u.pm >> 3) * 128 + (rloc - 128)) * 256 + cl; }
                }
#pragma unroll
                for (int bj = 0; bj < 2; ++bj) {
                    f32x4 v0 = (acc[ai][bj][m][0] + bv[bj][0]) * sc, v1 = (acc[ai][bj][m][1] + bv[bj][1]) * sc;
                    if (act) {
#pragma unroll
                        for (int j = 0; j < 4; ++j) { v0[j] = sigmoid_fast(v0[j]); v1[j] = sigmoid_fast(v1[j]); }
                    }
                    u32x4 w; w.x = pk2(v0[0], v0[1]); w.y = pk2(v0[2], v0[3]); w.z = pk2(v1[0], v1[1]); w.w = pk2(v1[2], v1[3]);
                    if (act) __builtin_nontemporal_store(w, (u32x4*)(rowp + bj * 128)); else *(u32x4*)(rowp + bj * 128) = w;
                    if (sp) { *(f32x4*)(sp + bj * 128) = v0; *(f32x4*)(sp + bj * 128 + 4) = v1; }
                }
            }
    }
};
template <int MODE> struct EpiF {
    static constexpr bool PERM = true;
    bf16* X; float* T1; const bf16* G; bf16* U; bf16* Xo;
    struct Pre { u32x2 g, x; f32x4 t; };
    __device__ __forceinline__ Pre pre(const size_t o) const { Pre p; p.g = (u32x2){0u, 0u}; p.x = (u32x2){0u, 0u}; p.t = (f32x4){0.f, 0.f, 0.f, 0.f};
        if (MODE == 0) p.g = *(const u32x2*)(G + o);
        if (MODE == 1) { p.g = *(const u32x2*)(G + o); p.x = *(const u32x2*)((const bf16*)T1 + o); }
        if (MODE == 2) p.x = *(const u32x2*)(X + o);
        if (MODE == 4) { p.x = *(const u32x2*)(X + o); const u32x2 tb = *(const u32x2*)((const bf16*)T1 + o); p.t = (f32x4){bflo(tb.x), bfhi(tb.x), bflo(tb.y), bfhi(tb.y)}; }
        return p; }
    __device__ __forceinline__ void fin(const size_t o, const f32x4 a, const Pre& p) const {
        if (MODE == 0) { u32x2 w; w.x = pk2(bflo(p.g.x) * a[0], bfhi(p.g.x) * a[1]); w.y = pk2(bflo(p.g.y) * a[2], bfhi(p.g.y) * a[3]); *(u32x2*)((bf16*)T1 + o) = w; }
        if (MODE == 1) { u32x2 w; w.x = pk2(bflo(p.x.x) + bflo(p.g.x) * a[0], bfhi(p.x.x) + bfhi(p.g.x) * a[1]); w.y = pk2(bflo(p.x.y) + bflo(p.g.y) * a[2], bfhi(p.x.y) + bfhi(p.g.y) * a[3]); *(u32x2*)(U + o) = w; }
        if (MODE == 2) { u32x2 w; w.x = pk2(bflo(p.x.x) * DN_ALPHA + a[0], bfhi(p.x.x) * DN_ALPHA + a[1]); w.y = pk2(bflo(p.x.y) * DN_ALPHA + a[2], bfhi(p.x.y) * DN_ALPHA + a[3]); *(u32x2*)(X + o) = w; }
        if (MODE == 3) { u32x2 w; w.x = pk2(a[0], a[1]); w.y = pk2(a[2], a[3]); *(u32x2*)((bf16*)T1 + o) = w; }
        if (MODE == 4) { u32x2 w; w.x = pk2(bflo(p.x.x) * DN_ALPHA + sigmoid_fast(a[0]) * p.t[0], bfhi(p.x.x) * DN_ALPHA + sigmoid_fast(a[1]) * p.t[1]); w.y = pk2(bflo(p.x.y) * DN_ALPHA + sigmoid_fast(a[2]) * p.t[2], bfhi(p.x.y) * DN_ALPHA + sigmoid_fast(a[3]) * p.t[3]);
            *(u32x2*)(Xo + o) = w; }
    }
    __device__ __forceinline__ void elem(const size_t o, const f32x4 a) const { fin(o, a, pre(o)); }
    __device__ __forceinline__ void op8(const size_t o, const f32x4 a0, const f32x4 a1) const {
        const float a[8] = {a0[0], a0[1], a0[2], a0[3], a1[0], a1[1], a1[2], a1[3]};
        u32x4 g = (u32x4){0u, 0u, 0u, 0u}, x = (u32x4){0u, 0u, 0u, 0u}, t = (u32x4){0u, 0u, 0u, 0u};
        if (MODE == 0 || MODE == 1) g = *(const u32x4*)(G + o);
        if (MODE == 1 || MODE == 4) t = *(const u32x4*)((const bf16*)T1 + o);
        if (MODE == 2 || MODE == 4) x = *(const u32x4*)(X + o);
        const unsigned gw[4] = {g.x, g.y, g.z, g.w}, xw[4] = {x.x, x.y, x.z, x.w}, tw[4] = {t.x, t.y, t.z, t.w};
        unsigned w[4];
#pragma unroll
        for (int q = 0; q < 4; ++q) { float lo = 0.f, hi = 0.f;
            if (MODE == 0) { lo = bflo(gw[q]) * a[2 * q]; hi = bfhi(gw[q]) * a[2 * q + 1]; }
            if (MODE == 1) { lo = bflo(tw[q]) + bflo(gw[q]) * a[2 * q]; hi = bfhi(tw[q]) + bfhi(gw[q]) * a[2 * q + 1]; }
            if (MODE == 2) { lo = bflo(xw[q]) * DN_ALPHA + a[2 * q]; hi = bfhi(xw[q]) * DN_ALPHA + a[2 * q + 1]; }
            if (MODE == 3) { lo = a[2 * q]; hi = a[2 * q + 1]; }
            if (MODE == 4) { lo = bflo(xw[q]) * DN_ALPHA + sigmoid_fast(a[2 * q]) * bflo(tw[q]); hi = bfhi(xw[q]) * DN_ALPHA + sigmoid_fast(a[2 * q + 1]) * bfhi(tw[q]); }
            w[q] = pk2(lo, hi); }
        const u32x4 ov = (u32x4){w[0], w[1], w[2], w[3]};
        if (MODE == 0 || MODE == 3) *(u32x4*)((bf16*)T1 + o) = ov;
        if (MODE == 1) *(u32x4*)(U + o) = ov;
        if (MODE == 2) *(u32x4*)(X + o) = ov;
        if (MODE == 4) *(u32x4*)(Xo + o) = ov;
    }
    __device__ __forceinline__ void operator()(const f32x4 (&acc)[2][2][4][2], const Unit& u, int wr, int wc, int fr, int fq) const {
        const int col0 = u.pn * 256 + wc * 32 + 8 * fq;
#pragma unroll
        for (int ai = 0; ai < 2; ++ai)
#pragma unroll
            for (int m = 0; m < 4; ++m) {
                const size_t off = ((size_t)u.pm * 256 + ai * 128 + wr * 64 + m * 16 + fr) * 1024 + col0;
#pragma unroll
                for (int bj = 0; bj < 2; ++bj) op8(off + bj * 128, acc[ai][bj][m][0], acc[ai][bj][m][1]);
                asm volatile("" ::: "memory");
            }
    }
};
struct EpiAB {
    static constexpr bool PERM = true;
    EpiF<0> e0; EpiF<1> e1;
    __device__ __forceinline__ void operator()(const f32x4 (&acc)[2][2][4][2], const Unit& u, int wr, int wc, int fr, int fq) const { if (u.sel == 0) e0(acc, u, wr, wc, fr, fq); else e1(acc, u, wr, wc, fr, fq); }
};
struct EpiGU {
    static constexpr bool PERM = true;
    bf16* H;
    __device__ __forceinline__ void operator()(const f32x4 (&acc)[2][2][4][2], const Unit& u, int wr, int wc, int fr, int fq) const {
        const int col0 = u.pn * 128 + wc * 32 + 8 * fq;
#pragma unroll
        for (int ai = 0; ai < 2; ++ai)
#pragma unroll
            for (int m = 0; m < 4; ++m) {
                bf16* rowp = H + ((size_t)u.pm * 256 + ai * 128 + wr * 64 + m * 16 + fr) * 512 + col0;
                float h[8];
#pragma unroll
                for (int n = 0; n < 2; ++n)
#pragma unroll
                    for (int j = 0; j < 4; ++j) { const float g = acc[ai][0][m][n][j], up = acc[ai][1][m][n][j]; h[n * 4 + j] = g * sigmoid_fast(g) * up; }
                u32x4 w; w.x = pk2(h[0], h[1]); w.y = pk2(h[2], h[3]); w.z = pk2(h[4], h[5]); w.w = pk2(h[6], h[7]);
                *(u32x4*)rowp = w;
            }
    }
};
struct EpiDN {
    static constexpr bool PERM = true;
    bf16* Y;
    __device__ __forceinline__ void operator()(const f32x4 (&acc)[2][2][4][2], const Unit& u, int wr, int wc, int fr, int fq) const {
        const int col0 = u.pn * 256 + wc * 32 + 8 * fq;
#pragma unroll
        for (int ai = 0; ai < 2; ++ai)
#pragma unroll
            for (int m = 0; m < 4; ++m) {
                bf16* rowp = Y + ((size_t)u.pm * 256 + ai * 128 + wr * 64 + m * 16 + fr) * 1024 + col0;
#pragma unroll
                for (int bj = 0; bj < 2; ++bj) { const f32x4 v0 = acc[ai][bj][m][0], v1 = acc[ai][bj][m][1];
                    u32x4 w; w.x = pk2(v0[0], v0[1]); w.y = pk2(v0[2], v0[3]); w.z = pk2(v1[0], v1[1]); w.w = pk2(v1[2], v1[3]);
                    *(u32x4*)(rowp + bj * 128) = w; }
            }
    }
};

struct Args { const float* in[28]; float* out; unsigned char* ws; int ph_lo, ph_hi; };
typedef __attribute__((address_space(4))) const Args CArgs;
struct Frame {
    LAS unsigned char* lds; volatile LAS unsigned* LW; unsigned* ctl;
    int tid, lane, wave, G, gw, NGW, bid;
    float* out; unsigned char* ws;
};
#define WSP(T_, off) ((T_*)(F.ws + (off)))
#define REFRESH_LANE(F_) do { unsigned z_ = 0u; asm volatile("" : "+s"(z_)); (F_).lane = (int)__builtin_amdgcn_mbcnt_hi(~0u, __builtin_amdgcn_mbcnt_lo(~0u, z_)); (F_).tid = (F_).wave * 64 + (F_).lane; } while (0)
#define WSW(T_, off, L_) ((T_*)(F.ws + (off) + (size_t)((L_) & 1) * WSET_SHIFT))

template <class Epi>
__device__ __forceinline__ void small_gemm(const Frame& F, const bf16* Aop, const bf16* Bop, const int K_, const Epi& E) {
    int K = K_; asm volatile("" : "+s"(K));
    for (int piece = F.bid; piece < 256; piece += F.G) {
    const int rt = piece & 7, ct = piece >> 3, fr = F.lane & 15, fq = F.lane >> 4;
    const int kw = K >> 3, k0 = F.wave * kw;
    const bf16* Ab = Aop + (size_t)(TP + 64 * rt + fr) * K + k0 + 8 * fq; const bf16* Bb = Bop + (size_t)(32 * ct + fr) * K + k0 + 8 * fq;
    const size_t eo = (size_t)(TP + 64 * rt + (F.tid >> 3)) * 1024 + 32 * ct + (F.tid & 7) * 4; const typename Epi::Pre ep = E.pre(eo);
    f32x4 acc[4][2];
#pragma unroll
    for (int mt = 0; mt < 4; ++mt)
#pragma unroll
        for (int nt = 0; nt < 2; ++nt) acc[mt][nt] = (f32x4){0.f, 0.f, 0.f, 0.f};
    if (kw == 128) {
        bf16x8 af[4][4], bf[2][4];
#pragma unroll
        for (int ks = 0; ks < 4; ++ks) {
#pragma unroll
            for (int mt = 0; mt < 4; ++mt) af[mt][ks] = *(const bf16x8*)(Ab + (size_t)(16 * mt) * K + 32 * ks);
#pragma unroll
            for (int nt = 0; nt < 2; ++nt) bf[nt][ks] = *(const bf16x8*)(Bb + (size_t)(16 * nt) * K + 32 * ks); }
#pragma unroll
        for (int ks = 0; ks < 4; ++ks)
#pragma unroll
            for (int mt = 0; mt < 4; ++mt)
#pragma unroll
                for (int nt = 0; nt < 2; ++nt) acc[mt][nt] = __builtin_amdgcn_mfma_f32_16x16x32_bf16(bf[nt][ks], af[mt][ks], acc[mt][nt], 0, 0, 0);
    } else {
        bf16x8 af[4], bf[2];
#pragma unroll
        for (int mt = 0; mt < 4; ++mt) af[mt] = *(const bf16x8*)(Ab + (size_t)(16 * mt) * K);
#pragma unroll
        for (int nt = 0; nt < 2; ++nt) bf[nt] = *(const bf16x8*)(Bb + (size_t)(16 * nt) * K);
#pragma unroll
        for (int mt = 0; mt < 4; ++mt)
#pragma unroll
            for (int nt = 0; nt < 2; ++nt) acc[mt][nt] = __builtin_amdgcn_mfma_f32_16x16x32_bf16(bf[nt], af[mt], acc[mt][nt], 0, 0, 0);
    }
    LAS float* red = (LAS float*)F.lds;
#pragma unroll
    for (int mt = 0; mt < 4; ++mt)
#pragma unroll
        for (int nt = 0; nt < 2; ++nt) *(LAS f32x4*)(red + (F.wave * 64 + 16 * mt + fr) * 32 + 16 * nt + 4 * fq) = acc[mt][nt];
    __syncthreads();
    { const int row = F.tid >> 3, c4 = (F.tid & 7) * 4; f32x4 s = *(const LAS f32x4*)(red + row * 32 + c4);
#pragma unroll
      for (int w = 1; w < 8; ++w) s += *(const LAS f32x4*)(red + (w * 64 + row) * 32 + c4);
      E.fin(eo, s, ep); }
    __syncthreads();
    }
}

template <bool NTST = false> __device__ __forceinline__ void tr_item(const float* W, int ldw, int K, bf16* WT, int kb, int nsrc0, int ndst0, LAS float* scr, int lane) {
    const int k0 = 64 * kb, r = lane >> 3, c4 = lane & 7;
    f32x4 x[8];
#pragma unroll
    for (int i = 0; i < 8; ++i) x[i] = __builtin_nontemporal_load((const f32x4*)(W + (size_t)(k0 + 8 * i + r) * ldw + nsrc0 + 4 * c4));
#pragma unroll
    for (int i = 0; i < 8; ++i) { LAS float* d = scr + (8 * i + r) * 33 + 4 * c4; d[0] = x[i][0]; d[1] = x[i][1]; d[2] = x[i][2]; d[3] = x[i][3]; }
    LDS_WAIT(); asm volatile("" ::: "memory");
    const int c = lane & 7;
#pragma unroll
    for (int j = 0; j < 4; ++j) { const int n = (lane >> 3) + 8 * j; const LAS float* s = scr + (8 * c) * 33 + n;
        u32x4 o; o.x = pk2(s[0 * 33], s[1 * 33]); o.y = pk2(s[2 * 33], s[3 * 33]); o.z = pk2(s[4 * 33], s[5 * 33]); o.w = pk2(s[6 * 33], s[7 * 33]);
        if (NTST) __builtin_nontemporal_store(o, (u32x4*)(WT + (size_t)(ndst0 + n) * K + k0 + 8 * c)); else *(u32x4*)(WT + (size_t)(ndst0 + n) * K + k0 + 8 * c) = o; }
    LDS_WAIT(); asm volatile("" ::: "memory");
}
constexpr int CV_I1 = 16 * 96, CV_I2 = 16 * 112, CV_I3 = 512, CV_IPP = 128, CV_IE = 8192, CV_N = CV_I1 + CV_I2 + 4 * CV_I3 + CV_IPP + 3 * CV_IE;
__device__ __forceinline__ void conv_item(CArgs& A, Frame& F, int L, int it) {
    LAS float* scr = (LAS float*)(F.lds + F.wave * 8704);
    int r = it;
    if (r < 2 * CV_IE) { const int up = r >= CV_IE; if (up) r -= CV_IE; const int e = r >> 8, q = r & 255, kb = q >> 4, nb = q & 15;
        tr_item<true>(A.in[up ? 24 : 23] + ((size_t)L * NEXP + e) * D * DEXP, DEXP, D, WSW(bf16, WS_WGU, L) + (size_t)e * D * D, kb, 32 * nb, 256 * (nb >> 2) + (up ? 128 : 0) + 32 * (nb & 3), scr, F.lane); return; } r -= 2 * CV_IE;
    if (r < CV_IE) { const int e = r >> 8, q = r & 255, kb = q >> 5, nb = q & 31;
        tr_item<true>(A.in[25] + ((size_t)L * NEXP + e) * DEXP * D, D, DEXP, WSW(bf16, WS_WD, L) + (size_t)e * D * DEXP, kb, 32 * nb, 32 * nb, scr, F.lane); return; } r -= CV_IE;
    const float* w_in = A.in[9] + (size_t)L * D * DIN;
    if (r < CV_I1) { tr_item(w_in, DIN, D, WSW(bf16, WS_WIN, L), r / 96, 32 * (r % 96), 32 * (r % 96), scr, F.lane); return; } r -= CV_I1;
    if (r < CV_I2) { tr_item(w_in, DIN, D, WSW(bf16, WS_WIN, L), r / 112, 3080 + 32 * (r % 112), 3072 + 32 * (r % 112), scr, F.lane); return; } r -= CV_I2;
    if (r < 4 * CV_I3) { const int which = r >> 9, q = r & 511; const float* srcw = A.in[which == 0 ? 12 : which == 1 ? 13 : which == 2 ? 14 : 26] + (size_t)L * D * D;
        tr_item(srcw, D, D, WSW(bf16, WS_WA, L) + (size_t)which * D * D, q / 32, 32 * (q % 32), 32 * (q % 32), scr, F.lane); return; } r -= 4 * CV_I3;
    tr_item(A.in[27] + (size_t)L * DPLE * D, D, DPLE, WSW(bf16, WS_WPP, L), r / 32, 32 * (r % 32), 32 * (r % 32), scr, F.lane);
}
__device__ __forceinline__ void convert_range(CArgs& A, Frame& F, int L, int lo, int hi, int nw, int r) {
    for (int it = lo + r * NW + F.wave; it < hi; it += nw * NW) conv_item(A, F, L, it);
}
constexpr int CV_G = 14000, CV_D = CV_G + 3200, CV_I = CV_D + 6400;
__device__ __forceinline__ void convert_layer(CArgs& A, Frame& F, int L, int lo) {
    convert_range(A, F, L, lo, CV_N, F.G, F.bid);
    { const float* w_rg = A.in[19] + (size_t)L * D * 4; const float* w_re = A.in[21] + (size_t)L * D * 32; bf16* Wh = WSP(bf16, WS_RW); bf16* Wl = Wh + 36 * 1032;
      for (int k = F.bid * NT + F.tid; k < D; k += F.G * NT) {
          float wv[36]; { const f32x4 g4 = *(const f32x4*)(w_rg + k * 4); wv[0] = g4[0]; wv[1] = g4[1]; wv[2] = g4[2]; wv[3] = g4[3]; }
#pragma unroll
          for (int c4 = 0; c4 < 8; ++c4) { const f32x4 e4 = *(const f32x4*)(w_re + k * 32 + 4 * c4); wv[4 + 4 * c4] = e4[0]; wv[5 + 4 * c4] = e4[1]; wv[6 + 4 * c4] = e4[2]; wv[7 + 4 * c4] = e4[3]; }
#pragma unroll
          for (int o = 0; o < 36; ++o) { const unsigned hi = f2bf(wv[o]); Wh[o * 1032 + k] = (bf16)hi; Wl[o * 1032 + k] = (bf16)f2bf(wv[o] - bf2f(hi)); } } }
    const float* pp = A.in[7] + (size_t)L * TP * DPLE; const float* ps = A.in[8] + (size_t)L * TS * DPLE; bf16* pb = WSP(bf16, WS_PB);
    for (size_t i = (size_t)F.bid * NT + F.tid; i < (size_t)T * DPLE / 8; i += (size_t)F.G * NT) {
        const size_t e0 = i * 8; const float* src = e0 < (size_t)TP * DPLE ? pp + e0 : ps + (e0 - (size_t)TP * DPLE);
        const f32x4 a = __builtin_nontemporal_load((const f32x4*)src), b = __builtin_nontemporal_load((const f32x4*)(src + 4));
        u32x4 w; w.x = pk2(a[0], a[1]); w.y = pk2(a[2], a[3]); w.z = pk2(b[0], b[1]); w.w = pk2(b[2], b[3]);
        *(u32x4*)(pb + e0) = w;
    }
}
constexpr int WIG_OFF = 73728;
__device__ __forceinline__ void stage_wig(CArgs& A, Frame& F, int L) {
    const float* w_in = A.in[9] + (size_t)L * D * DIN; LAS float* wig = (LAS float*)(F.lds + WIG_OFF);
    float t[16];
#pragma unroll
    for (int q = 0; q < 16; ++q) { const int i = F.tid + NT * q; t[q] = w_in[(size_t)(i >> 3) * DIN + 3072 + (i & 7)]; }
#pragma unroll
    for (int q = 0; q < 16; ++q) { const int i = F.tid + NT * q; wig[(i & 7) * 1024 + (i >> 3)] = t[q]; }
}
__device__ __forceinline__ void row_range(const Frame& F, int& m0, int& m1) { const int q = T / F.NGW, r = T % F.NGW; m0 = F.gw * q + (F.gw < r ? F.gw : r); m1 = m0 + q + (F.gw < r ? 1 : 0); }
#define RCOL(lane_, q_) (8 * (lane_) + 512 * ((q_) >> 1) + 4 * ((q_) & 1))
__device__ __forceinline__ void row_load(const float* p, int lane, f32x4 (&v)[4]) {
#pragma unroll
    for (int j = 0; j < 4; ++j) v[j] = *(const f32x4*)(p + RCOL(lane, j));
}
__device__ __forceinline__ void row_load_bf(const bf16* p, int lane, f32x4 (&v)[4]) {
#pragma unroll
    for (int j = 0; j < 2; ++j) { const u32x4 w = *(const u32x4*)(p + 8 * lane + 512 * j); v[2 * j] = (f32x4){bflo(w.x), bfhi(w.x), bflo(w.y), bfhi(w.y)}; v[2 * j + 1] = (f32x4){bflo(w.z), bfhi(w.z), bflo(w.w), bfhi(w.w)}; }
}
__device__ __forceinline__ void row_store_bf(bf16* p, int lane, const f32x4 (&v)[4]) {
#pragma unroll
    for (int j = 0; j < 2; ++j) { u32x4 w; w.x = pk2(v[2 * j][0], v[2 * j][1]); w.y = pk2(v[2 * j][2], v[2 * j][3]); w.z = pk2(v[2 * j + 1][0], v[2 * j + 1][1]); w.w = pk2(v[2 * j + 1][2], v[2 * j + 1][3]); *(u32x4*)(p + 8 * lane + 512 * j) = w; }
}
__device__ __forceinline__ void row_raw(const bf16* p, int lane, u32x4 (&r)[2]) { r[0] = *(const u32x4*)(p + 8 * lane); r[1] = *(const u32x4*)(p + 8 * lane + 512); }
__device__ __forceinline__ void row_unpack(const u32x4 (&r)[2], f32x4 (&v)[4]) {
#pragma unroll
    for (int j = 0; j < 2; ++j) { v[2 * j] = (f32x4){bflo(r[j].x), bfhi(r[j].x), bflo(r[j].y), bfhi(r[j].y)}; v[2 * j + 1] = (f32x4){bflo(r[j].z), bfhi(r[j].z), bflo(r[j].w), bfhi(r[j].w)}; }
}
__device__ __forceinline__ void row_ln(f32x4 (&v)[4], const float* g, const float* b, int lane) {
    float s = 0.f;
#pragma unroll
    for (int j = 0; j < 4; ++j) s += (v[j][0] + v[j][1]) + (v[j][2] + v[j][3]);
    const float mean = wave_sum(s) * (1.f / D); float s2 = 0.f;
#pragma unroll
    for (int j = 0; j < 4; ++j) { v[j] = v[j] - mean; s2 += (v[j][0] * v[j][0] + v[j][1] * v[j][1]) + (v[j][2] * v[j][2] + v[j][3] * v[j][3]); }
    const float rstd = 1.0f / sqrtf(wave_sum(s2) * (1.f / D) + LN_EPS);
#pragma unroll
    for (int j = 0; j < 4; ++j) { const f32x4 gg = *(const f32x4*)(g + RCOL(lane, j)), bb = *(const f32x4*)(b + RCOL(lane, j)); v[j] = v[j] * rstd * gg + bb; }
}
__device__ __forceinline__ void row_finalize(CArgs& A, Frame& F, int m, const f32x4 (&v)[4], int Ln) {
    row_store_bf(WSP(bf16, WS_X) + (size_t)m * D, F.lane, v);
    const LAS float* wig = (const LAS float*)(F.lds + WIG_OFF); const float* b_in = A.in[10] + (size_t)Ln * DIN + 3072;
    float r[8];
#pragma unroll
    for (int c = 0; c < 8; ++c) { float s = 0.f;
#pragma unroll
        for (int j = 0; j < 4; ++j) { const f32x4 w = *(const LAS f32x4*)(wig + c * 1024 + RCOL(F.lane, j)); s += (v[j][0] * w[0] + v[j][1] * w[1]) + (v[j][2] * w[2] + v[j][3] * w[3]); }
        r[c] = wave_sum(s); if (c & 1) asm volatile("" ::: "memory"); }
    if (F.lane < 8) { float x = r[0];
#pragma unroll
        for (int c = 1; c < 8; ++c) x = (F.lane == c) ? r[c] : x;
        WSP(float, WS_IGFG)[(size_t)m * 8 + F.lane] = x + b_in[F.lane]; }
}

constexpr int SQ_KS = 136, SQ_VS = 40;
constexpr int SQ_KW = 0, SQ_VT = 2 * 64 * SQ_KS * 2, SQ_G = SQ_VT + 2 * 64 * SQ_VS * 2, SQ_SC = SQ_G + 32 * 64 * 4;
__device__ __forceinline__ void mseq_item(Frame& F, int L, int item) {
    const int bh = item >> 3, vs = item & 7, b = bh >> 2, h = bh & 3;
    LAS float* sg = (LAS float*)(F.lds + SQ_G); LAS float* sbend = (LAS float*)(F.lds + SQ_SC); LAS float* sgmax = sbend + 32; LAS float* sdec = sbend + 64; LAS float* smn = sbend + 96;
    const float* igfg = WSP(float, WS_IGFG);
    { float igv[4], fgv[4];
#pragma unroll
      for (int i = 0; i < 4; ++i) { const int m = b * SEQ + (4 * F.wave + i) * 64 + F.lane; igv[i] = igfg[(size_t)m * 8 + h]; fgv[i] = igfg[(size_t)m * 8 + 4 + h]; }
#pragma unroll
      for (int i = 0; i < 4; ++i) { const int c = 4 * F.wave + i;
        float bc = log_sigmoid(fgv[i]);
#pragma unroll
        for (int o = 1; o < 64; o <<= 1) { const float t = bperm(bc, F.lane - o); if (F.lane >= o) bc += t; }
        const float bend = rdlane(bc, 63); const float g = igv[i] + bend - bc; const float gm = wave_max(g);
        sg[c * 64 + F.lane] = g; if (F.lane == 0) { sbend[c] = bend; sgmax[c] = gm; } } }
    __syncthreads();
    if (F.wave == 0) { const int c = F.lane & 31; const float bend = sbend[c], gmx = sgmax[c]; float a = bend, bq = gmx;
#pragma unroll
        for (int o = 1; o < 32; o <<= 1) { const float ta = bperm(a, F.lane - o), tb = bperm(bq, F.lane - o); if ((F.lane & 31) >= o) { bq = fmaxf(tb + a, bq); a = ta + a; } }
        const float mn = fmaxf(a, bq);
        float mp = bperm(mn, F.lane - 1); if ((F.lane & 31) == 0) mp = 0.f;
        if (F.lane < 32) { sdec[c] = expf(bend + mp - mn); smn[c] = mn; if (vs == 0) { WSP(float, WS_MC)[bh * 32 + c] = mp; if (c == 31) F.out[O_MP + (size_t)L * 32 + bh] = mn; } } }
    __syncthreads();
    for (int i = F.tid; i < 2048; i += NT) sg[i] = expf(sg[i] - smn[i >> 6]);
    __syncthreads();
    const bf16* Km = WSP(bf16, WS_KM); const bf16* Vm = WSP(bf16, WS_VM);
    const int fr = F.lane & 15, fq = F.lane >> 4, tr_r = (F.lane & 15) >> 2, tr_c = F.lane & 3;
    const int ktok = F.tid >> 4, kd8 = F.tid & 15, vtok = (F.tid >> 2) & 63, vv8 = F.tid & 3;
    const bf16* kp = Km + (size_t)(b * SEQ + ktok) * 512 + h * 128 + kd8 * 8; const bf16* vp = Vm + (size_t)(b * SEQ + vtok) * 1024 + h * 256 + 32 * vs + vv8 * 8;
    const size_t kcs = (size_t)64 * 512, vcs = (size_t)64 * 1024;
    u32x4 rkA0 = *(const u32x4*)kp, rkA1 = *(const u32x4*)(kp + 32 * 512), rvA = *(const u32x4*)vp;
    u32x4 rkB0 = *(const u32x4*)(kp + kcs), rkB1 = *(const u32x4*)(kp + kcs + 32 * 512), rvB = *(const u32x4*)(vp + vcs);
    u32x4 rkC0 = *(const u32x4*)(kp + 2 * kcs), rkC1 = *(const u32x4*)(kp + 2 * kcs + 32 * 512), rvC = *(const u32x4*)(vp + 2 * vcs);
    u32x4 rkD0 = *(const u32x4*)(kp + 3 * kcs), rkD1 = *(const u32x4*)(kp + 3 * kcs + 32 * 512), rvD = *(const u32x4*)(vp + 3 * vcs);
    f32x4 acc[2] = {(f32x4){0.f, 0.f, 0.f, 0.f}, (f32x4){0.f, 0.f, 0.f, 0.f}}, nacc = (f32x4){0.f, 0.f, 0.f, 0.f};
    const u32x4 onesw = (u32x4){0x3f803f80u, 0x3f803f80u, 0x3f803f80u, 0x3f803f80u}; const bf16x8 ones = __builtin_bit_cast(bf16x8, onesw);
    bf16* Cc = WSP(bf16, WS_CC); float* NCp = WSP(float, WS_NC);
    const unsigned ldsb = lds_addr(F.lds);
#define MSEQ_STEP(c, rk0, rk1, rv) { \
        LAS bf16* kw = (LAS bf16*)(F.lds + SQ_KW + ((c) & 1) * (64 * SQ_KS * 2)); LAS bf16* vl = (LAS bf16*)(F.lds + SQ_VT + ((c) & 1) * (64 * SQ_VS * 2)); \
        { const float s0 = sg[(c) * 64 + ktok], s1 = sg[(c) * 64 + ktok + 32]; u32x4 w0, w1; \
          w0.x = pk2(bflo(rk0.x) * s0, bfhi(rk0.x) * s0); w0.y = pk2(bflo(rk0.y) * s0, bfhi(rk0.y) * s0); w0.z = pk2(bflo(rk0.z) * s0, bfhi(rk0.z) * s0); w0.w = pk2(bflo(rk0.w) * s0, bfhi(rk0.w) * s0); \
          w1.x = pk2(bflo(rk1.x) * s1, bfhi(rk1.x) * s1); w1.y = pk2(bflo(rk1.y) * s1, bfhi(rk1.y) * s1); w1.z = pk2(bflo(rk1.z) * s1, bfhi(rk1.z) * s1); w1.w = pk2(bflo(rk1.w) * s1, bfhi(rk1.w) * s1); \
          *(LAS u32x4*)(kw + ktok * SQ_KS + kd8 * 8) = w0; *(LAS u32x4*)(kw + (ktok + 32) * SQ_KS + kd8 * 8) = w1; \
          if (F.tid < 256) *(LAS u32x4*)(vl + vtok * SQ_VS + vv8 * 8) = rv; } \
        if ((c) > 0) { const size_t ci = (size_t)(bh * 32 + (c)); \
            _Pragma("unroll") for (int nt = 0; nt < 2; ++nt) { u32x2 w; w.x = pk2(acc[nt][0], acc[nt][1]); w.y = pk2(acc[nt][2], acc[nt][3]); *(u32x2*)(Cc + ci * 32768 + (size_t)(32 * vs + 16 * nt + fr) * 128 + 16 * F.wave + 4 * fq) = w; } \
            if (vs == 0 && fr == 0) *(f32x4*)(NCp + ci * 128 + 16 * F.wave + 4 * fq) = nacc; } \
        __syncthreads(); \
        if ((c) + 4 < 32) { rk0 = *(const u32x4*)(kp + (size_t)((c) + 4) * kcs); rk1 = *(const u32x4*)(kp + (size_t)((c) + 4) * kcs + 32 * 512); rv = *(const u32x4*)(vp + (size_t)((c) + 4) * vcs); } \
        const float dec = sdec[(c)]; \
        acc[0] = acc[0] * dec; acc[1] = acc[1] * dec; nacc = nacc * dec; \
        const unsigned kb = ldsb + SQ_KW + ((c) & 1) * (64 * SQ_KS * 2), vb = ldsb + SQ_VT + ((c) & 1) * (64 * SQ_VS * 2); \
        _Pragma("unroll") for (int ks = 0; ks < 2; ++ks) { const int t0 = 32 * ks + 8 * fq + tr_r; \
            const bf16x8 kf = tr_frag(kb + (unsigned)((t0 * SQ_KS + 16 * F.wave + 4 * tr_c) * 2), kb + (unsigned)(((t0 + 4) * SQ_KS + 16 * F.wave + 4 * tr_c) * 2)); \
            _Pragma("unroll") for (int nt = 0; nt < 2; ++nt) { const bf16x8 vf = tr_frag(vb + (unsigned)((t0 * SQ_VS + 16 * nt + 4 * tr_c) * 2), vb + (unsigned)(((t0 + 4) * SQ_VS + 16 * nt + 4 * tr_c) * 2)); \
                acc[nt] = __builtin_amdgcn_mfma_f32_16x16x32_bf16(kf, vf, acc[nt], 0, 0, 0); } \
            nacc = __builtin_amdgcn_mfma_f32_16x16x32_bf16(kf, ones, nacc, 0, 0, 0); } }
#pragma unroll 1
    for (int c = 0; c < 32; c += 4) { MSEQ_STEP(c, rkA0, rkA1, rvA) MSEQ_STEP(c + 1, rkB0, rkB1, rvB) MSEQ_STEP(c + 2, rkC0, rkC1, rvC) MSEQ_STEP(c + 3, rkD0, rkD1, rvD) }
#undef MSEQ_STEP
    float* Cp = F.out + O_CP + ((size_t)L * 32 + bh) * 32768;
#pragma unroll
    for (int nt = 0; nt < 2; ++nt)
#pragma unroll
        for (int j = 0; j < 4; ++j) Cp[(size_t)(16 * F.wave + 4 * fq + j) * 256 + 32 * vs + 16 * nt + fr] = acc[nt][j];
    if (vs == 0 && fr == 0) *(f32x4*)(F.out + O_NP + ((size_t)L * 32 + bh) * 128 + 16 * F.wave + 4 * fq) = nacc;
    __syncthreads();
}
constexpr int M4_VS = 264;
constexpr int M4_Q = 0, M4_K = 64 * 136 * 2, M4_VT = M4_K + 64 * 136 * 2, M4_CT = M4_VT + 64 * M4_VS * 2, M4_S = M4_CT + 256 * 136 * 2;
__device__ __forceinline__ void m4_item(CArgs& A, Frame& F, int L, int item) {
    const int bh = item >> 5, c = item & 31, b = bh >> 2, h = bh & 3; const int tok0 = b * SEQ + c * 64;
    LAS bf16* qs = (LAS bf16*)(F.lds + M4_Q); LAS bf16* ks_ = (LAS bf16*)(F.lds + M4_K); LAS bf16* vT = (LAS bf16*)(F.lds + M4_VT); LAS bf16* CT = (LAS bf16*)(F.lds + M4_CT);
    LAS float* sa = (LAS float*)(F.lds + M4_S); LAS float* sM = sa + 64; LAS float* sW = sa + 128; LAS float* sE = sa + 192; LAS float* sn = sa + 256; LAS float* red = sa + 384; LAS float* red2 = sa + 512;
    const float* igfg = WSP(float, WS_IGFG);
    if (F.wave == 0) {
        const float m_c = WSP(float, WS_MC)[item];
        const int m = tok0 + F.lane; const float ig = igfg[(size_t)m * 8 + h], fg = igfg[(size_t)m * 8 + 4 + h];
        float bc = log_sigmoid(fg);
#pragma unroll
        for (int o = 1; o < 64; o <<= 1) { const float t = bperm(bc, F.lane - o); if (F.lane >= o) bc += t; }
        const float a = ig - bc; float pm = a;
#pragma unroll
        for (int o = 1; o < 64; o <<= 1) { const float t = bperm(pm, F.lane - o); if (F.lane >= o) pm = fmaxf(pm, t); }
        const float M = fmaxf(m_c, pm);
        sa[F.lane] = a; sM[F.lane] = M; sW[F.lane] = expf(m_c - M); sE[F.lane] = expf(-(bc + M));
    }
    const bf16* Qm = WSP(bf16, WS_QM); const bf16* Km = WSP(bf16, WS_KM); const bf16* Vm = WSP(bf16, WS_VM);
#pragma unroll
    for (int i = 0; i < 2; ++i) { const int idx = F.tid + NT * i, tok = idx >> 4, d8 = idx & 15;
        *(LAS u32x4*)(qs + tok * 136 + d8 * 8) = *(const u32x4*)(Qm + (size_t)(tok0 + tok) * 512 + h * 128 + d8 * 8);
        *(LAS u32x4*)(ks_ + tok * 136 + d8 * 8) = *(const u32x4*)(Km + (size_t)(tok0 + tok) * 512 + h * 128 + d8 * 8); }
    u32x4 rv[4], rc[8];
#pragma unroll
    for (int i = 0; i < 4; ++i) { const int idx = F.tid + NT * i, tok = idx >> 5, v8 = idx & 31; rv[i] = *(const u32x4*)(Vm + (size_t)(tok0 + tok) * 1024 + h * 256 + v8 * 8); }
    if (c > 0) {
        const bf16* Cc = WSP(bf16, WS_CC) + (size_t)item * 32768;
#pragma unroll
        for (int i = 0; i < 8; ++i) { const int idx = F.tid + NT * i, vc = idx >> 4, d8 = idx & 15; rc[i] = *(const u32x4*)(Cc + vc * 128 + d8 * 8); }
        if (F.tid < 128) sn[F.tid] = WSP(float, WS_NC)[(size_t)item * 128 + F.tid];
    } else { if (F.tid < 128) sn[F.tid] = 0.f;
#pragma unroll
        for (int i = 0; i < 8; ++i) rc[i] = (u32x4){0u, 0u, 0u, 0u}; }
    __syncthreads();
    const int fr = F.lane & 15, fq = F.lane >> 4, lt = F.wave & 3, vh = F.wave >> 2, l = 16 * lt + fr;
    bf16x8 qf[4];
#pragma unroll
    for (int ks = 0; ks < 4; ++ks) qf[ks] = *(const LAS bf16x8*)(qs + l * 136 + 32 * ks + 8 * fq);
    const float Ml = sM[l], wl = sW[l];
    float sw[4][4]; float rs = 0.f;
#pragma unroll
    for (int st = 0; st < 4; ++st) {
        f32x4 acc = (f32x4){0.f, 0.f, 0.f, 0.f};
#pragma unroll
        for (int ks = 0; ks < 4; ++ks) { const bf16x8 kf = *(const LAS bf16x8*)(ks_ + (16 * st + fr) * 136 + 32 * ks + 8 * fq); acc = __builtin_amdgcn_mfma_f32_16x16x32_bf16(kf, qf[ks], acc, 0, 0, 0); }
#pragma unroll
        for (int j = 0; j < 4; ++j) { const int s = 16 * st + 4 * fq + j; const float w = (s <= l) ? __expf(sa[s] - Ml) : 0.f; sw[st][j] = acc[j] * w; rs += sw[st][j]; }
    }
    rs += bperm(rs, F.lane ^ 16); rs += bperm(rs, F.lane ^ 32);
    float qn = 0.f;
#pragma unroll
    for (int ks = 0; ks < 4; ++ks)
#pragma unroll
        for (int e = 0; e < 8; ++e) qn += bf2f((unsigned short)qf[ks][e]) * sn[32 * ks + 8 * fq + e];
    qn += bperm(qn, F.lane ^ 16); qn += bperm(qn, F.lane ^ 32);
    const float den = rs + wl * qn; const float inv = 1.0f / fmaxf(fabsf(den), sE[l]);
    bf16x8 pf[2], qsf[4];
#pragma unroll
    for (int k2 = 0; k2 < 2; ++k2) { u32x4 w; w.x = pk2(sw[2 * k2][0], sw[2 * k2][1]); w.y = pk2(sw[2 * k2][2], sw[2 * k2][3]); w.z = pk2(sw[2 * k2 + 1][0], sw[2 * k2 + 1][1]); w.w = pk2(sw[2 * k2 + 1][2], sw[2 * k2 + 1][3]);
        pf[k2] = __builtin_bit_cast(bf16x8, w); }
#pragma unroll
    for (int ks = 0; ks < 4; ++ks) { u32x4 w;
        w.x = pk2(bf2f((unsigned short)qf[ks][0]) * wl, bf2f((unsigned short)qf[ks][1]) * wl); w.y = pk2(bf2f((unsigned short)qf[ks][2]) * wl, bf2f((unsigned short)qf[ks][3]) * wl);
        w.z = pk2(bf2f((unsigned short)qf[ks][4]) * wl, bf2f((unsigned short)qf[ks][5]) * wl); w.w = pk2(bf2f((unsigned short)qf[ks][6]) * wl, bf2f((unsigned short)qf[ks][7]) * wl);
        qsf[ks] = __builtin_bit_cast(bf16x8, w); }
#pragma unroll
    for (int i = 0; i < 4; ++i) { const int idx = F.tid + NT * i, tok = idx >> 5, v8 = idx & 31; *(LAS u32x4*)(vT + tok * M4_VS + v8 * 8) = rv[i]; }
#pragma unroll
    for (int i = 0; i < 8; ++i) { const int idx = F.tid + NT * i, vc = idx >> 4, d8 = idx & 15; *(LAS u32x4*)(CT + vc * 136 + d8 * 8) = rc[i]; }
    u32x2 ogv[8];
    { const bf16* og_ = WSP(bf16, WS_OG) + (size_t)(tok0 + 16 * (F.wave & 3) + (F.lane & 15)) * D + h * 256;
#pragma unroll
      for (int nt = 0; nt < 8; ++nt) ogv[nt] = *(const u32x2*)(og_ + 128 * (F.wave >> 2) + 16 * nt + 4 * (F.lane >> 4)); }
    __syncthreads();
    f32x4 hv[8]; float s1 = 0.f; const unsigned vtb = lds_addr(F.lds) + M4_VT;
#pragma unroll
    for (int nt = 0; nt < 8; ++nt) {
        const int vrow = 128 * vh + 16 * nt + fr;
        f32x4 acc = (f32x4){0.f, 0.f, 0.f, 0.f};
#pragma unroll
        for (int k2 = 0; k2 < 2; ++k2) { const int T0 = 32 * k2 + 4 * fq + ((F.lane & 15) >> 2); const unsigned cb = (unsigned)((128 * vh + 16 * nt + 4 * (F.lane & 3)) * 2);
            const bf16x8 vf = tr_frag(vtb + (unsigned)(T0 * M4_VS * 2) + cb, vtb + (unsigned)((T0 + 16) * M4_VS * 2) + cb);
            acc = __builtin_amdgcn_mfma_f32_16x16x32_bf16(vf, pf[k2], acc, 0, 0, 0); }
#pragma unroll
        for (int ks = 0; ks < 4; ++ks) { const bf16x8 cf = *(const LAS bf16x8*)(CT + vrow * 136 + 32 * ks + 8 * fq); acc = __builtin_amdgcn_mfma_f32_16x16x32_bf16(cf, qsf[ks], acc, 0, 0, 0); }
        hv[nt] = acc * inv; s1 += (hv[nt][0] + hv[nt][1]) + (hv[nt][2] + hv[nt][3]);
    }
    s1 += bperm(s1, F.lane ^ 16); s1 += bperm(s1, F.lane ^ 32);
    if (fq == 0) red[l * 2 + vh] = s1;
    __syncthreads();
    const float mean = (red[l * 2] + red[l * 2 + 1]) * (1.f / 256.f); float s2 = 0.f;
#pragma unroll
    for (int nt = 0; nt < 8; ++nt) { hv[nt] = hv[nt] - mean; s2 += (hv[nt][0] * hv[nt][0] + hv[nt][1] * hv[nt][1]) + (hv[nt][2] * hv[nt][2] + hv[nt][3] * hv[nt][3]); }
    s2 += bperm(s2, F.lane ^ 16); s2 += bperm(s2, F.lane ^ 32);
    if (fq == 0) red2[l * 2 + vh] = s2;
    __syncthreads();
    const float rstd = 1.0f / sqrtf((red2[l * 2] + red2[l * 2 + 1]) * (1.f / 256.f) + LN_EPS);
    const float* gain = A.in[11] + (size_t)L * D + h * 256; bf16* ya = WSP(bf16, WS_YA) + (size_t)(tok0 + l) * D + h * 256;
#pragma unroll
    for (int nt = 0; nt < 8; ++nt) { const int vc = 128 * vh + 16 * nt + 4 * fq;
        const f32x4 g = *(const f32x4*)(gain + vc); const u32x2 o = ogv[nt];
        u32x2 w; w.x = pk2(hv[nt][0] * rstd * g[0] * bflo(o.x), hv[nt][1] * rstd * g[1] * bfhi(o.x)); w.y = pk2(hv[nt][2] * rstd * g[2] * bflo(o.y), hv[nt][3] * rstd * g[3] * bfhi(o.y));
        *(u32x2*)(ya + vc) = w; }
    __syncthreads();
}

constexpr int MS_Q = 0, MS_K = 2048, MS_V = 4096, MS_S = 8192, MS_RED = 8704;
constexpr int MS_LN = MS_RED + 32768;
__device__ __forceinline__ void ms_item(CArgs& A, Frame& F, int L, int item) {
    const int b = item >> 2, h = item & 3; const int tok0 = TP + b * 4;
    LAS float* sq = (LAS float*)(F.lds + MS_Q); LAS float* sk = (LAS float*)(F.lds + MS_K); LAS float* sv = (LAS float*)(F.lds + MS_V); LAS float* sS = (LAS float*)(F.lds + MS_S);
    LAS float* red = (LAS float*)(F.lds + MS_RED); LAS float* lnb = (LAS float*)(F.lds + MS_LN);
    const size_t sidx = ((size_t)L * 128 + b) * 4 + h;
    const float* C0 = A.in[2] + sidx * 32768; const float* n0 = A.in[3] + sidx * 128; const float m0 = A.in[4][sidx];
    const bf16* Qm = WSP(bf16, WS_QM); const bf16* Km = WSP(bf16, WS_KM); const bf16* Vm = WSP(bf16, WS_VM); const float* igfg = WSP(float, WS_IGFG);
    { const int t = F.tid >> 7, d = F.tid & 127; sq[F.tid] = bf2f(Qm[(size_t)(tok0 + t) * 512 + h * 128 + d]); sk[F.tid] = bf2f(Km[(size_t)(tok0 + t) * 512 + h * 128 + d]); }
#pragma unroll
    for (int i = 0; i < 2; ++i) { const int idx = F.tid + NT * i, t = idx >> 8, vc = idx & 255; sv[idx] = bf2f(Vm[(size_t)(tok0 + t) * 1024 + h * 256 + vc]); }
    float ig[4], bc[4], a[4], M[4], wint[4], elim[4], ksc[4];
    { float run = 0.f, pm = -INFINITY;
#pragma unroll
      for (int t = 0; t < 4; ++t) { ig[t] = igfg[(size_t)(tok0 + t) * 8 + h]; run += log_sigmoid(igfg[(size_t)(tok0 + t) * 8 + 4 + h]); bc[t] = run; a[t] = ig[t] - run; pm = fmaxf(pm, a[t]);
          M[t] = fmaxf(m0, pm); wint[t] = expf(m0 - M[t]); elim[t] = expf(-(run + M[t])); } }
    const float bend = bc[3]; float gmax = -INFINITY;
#pragma unroll
    for (int t = 0; t < 4; ++t) gmax = fmaxf(gmax, ig[t] + bend - bc[t]);
    const float mnew = fmaxf(bend + m0, gmax), decay = expf(bend + m0 - mnew);
#pragma unroll
    for (int t = 0; t < 4; ++t) ksc[t] = expf(ig[t] + bend - bc[t] - mnew);
    __syncthreads();
    for (int p = F.wave; p < 20; p += NW) {
        float s;
        if (p < 16) { const int t = p >> 2, s_ = p & 3; s = sq[t * 128 + F.lane] * sk[s_ * 128 + F.lane] + sq[t * 128 + 64 + F.lane] * sk[s_ * 128 + 64 + F.lane]; }
        else { const int t = p - 16; s = sq[t * 128 + F.lane] * n0[F.lane] + sq[t * 128 + 64 + F.lane] * n0[64 + F.lane]; }
        s = wave_sum(s);
        if (F.lane == 0) sS[p] = s;
    }
    __syncthreads();
    const int v4 = (F.tid & 63) * 4, dg = F.tid >> 6;
    f32x4 qc[4]; f32x4 vs4[4];
#pragma unroll
    for (int t = 0; t < 4; ++t) { qc[t] = (f32x4){0.f, 0.f, 0.f, 0.f}; vs4[t] = *(const LAS f32x4*)(sv + t * 256 + v4); }
    float* Cout = F.out + O_CS + sidx * 32768;
    f32x4 c0a[16];
#pragma unroll
    for (int dd = 0; dd < 16; ++dd) c0a[dd] = __builtin_nontemporal_load((const f32x4*)(C0 + (16 * dg + dd) * 256 + v4));
#pragma unroll
    for (int dd = 0; dd < 16; ++dd) { const int d = 16 * dg + dd;
        const f32x4 c0 = c0a[dd]; f32x4 cn = c0 * decay;
#pragma unroll
        for (int t = 0; t < 4; ++t) { qc[t] += c0 * sq[t * 128 + d]; cn += vs4[t] * (sk[t * 128 + d] * ksc[t]); }
        __builtin_nontemporal_store(cn, (f32x4*)(Cout + d * 256 + v4)); }
#pragma unroll
    for (int t = 0; t < 4; ++t) *(LAS f32x4*)(red + (dg * 4 + t) * 256 + v4) = qc[t];
    if (F.tid >= 256 && F.tid < 384) { const int d = F.tid - 256; float nn = n0[d] * decay;
#pragma unroll
        for (int t = 0; t < 4; ++t) nn += sk[t * 128 + d] * ksc[t];
        F.out[O_NS + sidx * 128 + d] = nn; }
    if (F.tid == 0) F.out[O_MS + sidx] = mnew;
    __syncthreads();
    float hval[4];
    if (F.tid < 256) { const int vc = F.tid;
#pragma unroll
        for (int t = 0; t < 4; ++t) { float qC = 0.f;
#pragma unroll
            for (int g = 0; g < 8; ++g) qC += red[(g * 4 + t) * 256 + vc];
            float num = wint[t] * qC, den = wint[t] * sS[16 + t];
#pragma unroll
            for (int s = 0; s < 4; ++s) if (s <= t) { const float w = sS[t * 4 + s] * expf(a[s] - M[t]); num += w * sv[s * 256 + vc]; den += w; }
            hval[t] = num / fmaxf(fabsf(den), elim[t]);
            const float ws = wave_sum(hval[t]); if (F.lane == 0) lnb[t * 4 + F.wave] = ws; }
    }
    __syncthreads();
    float mean[4];
    if (F.tid < 256) {
#pragma unroll
        for (int t = 0; t < 4; ++t) { mean[t] = (lnb[t * 4] + lnb[t * 4 + 1] + lnb[t * 4 + 2] + lnb[t * 4 + 3]) * (1.f / 256.f); hval[t] -= mean[t];
            const float ws = wave_sum(hval[t] * hval[t]); if (F.lane == 0) lnb[16 + t * 4 + F.wave] = ws; }
    }
    __syncthreads();
    if (F.tid < 256) { const int vc = F.tid; const float gain = A.in[11][(size_t)L * D + h * 256 + vc];
#pragma unroll
        for (int t = 0; t < 4; ++t) { const float var = (lnb[16 + t * 4] + lnb[16 + t * 4 + 1] + lnb[16 + t * 4 + 2] + lnb[16 + t * 4 + 3]) * (1.f / 256.f);
            const float rstd = 1.0f / sqrtf(var + LN_EPS); const size_t o = (size_t)(tok0 + t) * D + h * 256 + vc;
            WSP(bf16, WS_YA)[o] = (bf16)f2bf(hval[t] * rstd * gain * bf2f(WSP(bf16, WS_OG)[o])); }
    }
    __syncthreads();
}

constexpr int SW_K = 0, SW_VT = 256 * 72 * 2, SW_BT = SW_VT + 272 * 72 * 2, SW_WAVE = SW_BT + 16 * 132 * 4;
__device__ __forceinline__ void swa_build_bias(CArgs& A, Frame& F) {
    LAS float* bt = (LAS float*)(F.lds + SW_BT); const float* rel = A.in[15];
    for (int i = F.tid; i < 16 * 132; i += NT) { const int h = i / 132, dist = i % 132; bt[i] = rel[RELB[dist] * 16 + h]; }
}
__device__ __forceinline__ void swa_item(CArgs& A, Frame& F, int L, int item) {
    const int b = item >> 6, blk = (item >> 2) & 15, kvh = item & 3;
    LAS bf16* Kl = (LAS bf16*)(F.lds + SW_K); LAS bf16* VT = (LAS bf16*)(F.lds + SW_VT); const LAS float* bt = (const LAS float*)(F.lds + SW_BT);
    const bf16* Ks = WSP(bf16, WS_KS); const bf16* Vs = WSP(bf16, WS_VS); const bf16* Qs = WSP(bf16, WS_QS); bf16* yb = WSP(bf16, WS_YB);
    bf16x8 qn[2];
    const bf16* qbase = Qs + ((size_t)b * SEQ + blk * 128 + 64 * (F.wave >> 2) + (F.lane & 15)) * D + (kvh * 4 + (F.wave & 3)) * 64 + 8 * (F.lane >> 4);
    qn[0] = *(const bf16x8*)qbase; qn[1] = *(const bf16x8*)(qbase + 32);
#pragma unroll
    for (int i = 0; i < 4; ++i) { const int idx = F.tid + NT * i, key = idx >> 3, d8 = idx & 7; const int tr = (blk - 1) * 128 + key;
        u32x4 raw = (u32x4){0u, 0u, 0u, 0u}; if (tr >= 0) raw = *(const u32x4*)(Ks + (size_t)(b * SEQ + tr) * 256 + kvh * 64 + d8 * 8);
        *(LAS u32x4*)(Kl + key * 72 + d8 * 8) = raw; }
#pragma unroll
    for (int i = 0; i < 4; ++i) { const int idx = F.tid + NT * i, key = idx >> 3, d8 = idx & 7; const int tr = (blk - 1) * 128 + key;
        u32x4 raw = (u32x4){0u, 0u, 0u, 0u}; if (tr >= 0) raw = *(const u32x4*)(Vs + (size_t)(b * SEQ + tr) * 256 + kvh * 64 + d8 * 8);
        *(LAS u32x4*)(VT + key * 72 + d8 * 8) = raw; }
    if (F.tid < 16 * 9) { unsigned zz = 0u; asm volatile("" : "+v"(zz)); *(LAS u32x4*)(VT + (256 + F.tid / 9) * 72 + (F.tid % 9) * 8) = (u32x4){zz, zz, zz, zz}; }
    __syncthreads();
    const int fr = F.lane & 15, fq = F.lane >> 4, g2 = F.wave & 3, qh = F.wave >> 2, hq = kvh * 4 + g2, q0 = 64 * qh;
    const float sink = A.in[16][L * 16 + hq]; const unsigned vtb = lds_addr(F.lds) + SW_VT;
    float bias[9][4];
#pragma unroll
    for (int st = 0; st < 9; ++st)
#pragma unroll
        for (int j = 0; j < 4; ++j) { const int srel = 16 * st + 4 * fq + j; const int dist = fr + 128 - srel; bias[st][j] = ((srel >= fr) && (dist >= 0)) ? bt[hq * 132 + (dist < 0 ? 0 : dist)] : -INFINITY; }
#pragma unroll 1
    for (int lt = 0; lt < 4; ++lt) {
        const int kbase = q0 + 16 * lt; const size_t m = (size_t)b * SEQ + blk * 128 + kbase + fr;
        bf16x8 qf[2]; qf[0] = qn[0]; qf[1] = qn[1];
        if (lt < 3) { qn[0] = *(const bf16x8*)(qbase + (size_t)(16 * (lt + 1)) * D); qn[1] = *(const bf16x8*)(qbase + (size_t)(16 * (lt + 1)) * D + 32); }
        float sv[9][4]; float mx = -INFINITY;
#pragma unroll
        for (int st = 0; st < 9; ++st) {
            f32x4 acc = (f32x4){0.f, 0.f, 0.f, 0.f};
#pragma unroll
            for (int ks = 0; ks < 2; ++ks) { const bf16x8 kf = *(const LAS bf16x8*)(Kl + (kbase + 16 * st + fr) * 72 + 32 * ks + 8 * fq); acc = __builtin_amdgcn_mfma_f32_16x16x32_bf16(kf, qf[ks], acc, 0, 0, 0); }
#pragma unroll
            for (int j = 0; j < 4; ++j) { float x = acc[j] + bias[st][j];
                if (blk == 0) { const int srel = 16 * st + 4 * fq + j; x = (kbase + srel >= 128) ? x : -INFINITY; }
                sv[st][j] = x; mx = fmaxf(mx, x); }
        }
        mx = fmaxf(mx, bperm(mx, F.lane ^ 16)); mx = fmaxf(mx, bperm(mx, F.lane ^ 32)); mx = fmaxf(mx, sink);
        const float mxl = mx * LOG2E; float sum = 0.f;
#pragma unroll
        for (int st = 0; st < 9; ++st)
#pragma unroll
            for (int j = 0; j < 4; ++j) { const float p = __builtin_amdgcn_exp2f(__builtin_fmaf(sv[st][j], LOG2E, -mxl)); sv[st][j] = p; sum += p; }
        sum += bperm(sum, F.lane ^ 16); sum += bperm(sum, F.lane ^ 32);
        const float inv = 1.0f / (sum + __builtin_amdgcn_exp2f(__builtin_fmaf(sink, LOG2E, -mxl)));
        f32x4 o[4];
#pragma unroll
        for (int nt = 0; nt < 4; ++nt) o[nt] = (f32x4){0.f, 0.f, 0.f, 0.f};
#pragma unroll
        for (int k2 = 0; k2 < 5; ++k2) {
            u32x4 pw; pw.x = pk2(sv[2 * k2][0], sv[2 * k2][1]); pw.y = pk2(sv[2 * k2][2], sv[2 * k2][3]);
            if (k2 < 4) { pw.z = pk2(sv[2 * k2 + 1 > 8 ? 8 : 2 * k2 + 1][0], sv[2 * k2 + 1 > 8 ? 8 : 2 * k2 + 1][1]); pw.w = pk2(sv[2 * k2 + 1 > 8 ? 8 : 2 * k2 + 1][2], sv[2 * k2 + 1 > 8 ? 8 : 2 * k2 + 1][3]); } else { pw.z = 0u; pw.w = 0u; }
            const bf16x8 pf = __builtin_bit_cast(bf16x8, pw);
            { const int T0 = kbase + 32 * k2 + 4 * fq + ((F.lane & 15) >> 2); const unsigned a0 = vtb + (unsigned)((T0 * 72 + 4 * (F.lane & 3)) * 2);
              bf16x8 vf[4]; tr_frag4(a0, a0 + 16 * 72 * 2, 32u, vf);
#pragma unroll
              for (int nt = 0; nt < 4; ++nt) o[nt] = __builtin_amdgcn_mfma_f32_16x16x32_bf16(vf[nt], pf, o[nt], 0, 0, 0); }
        }
#pragma unroll
        for (int nt = 0; nt < 4; ++nt) { u32x2 w; w.x = pk2(o[nt][0] * inv, o[nt][1] * inv); w.y = pk2(o[nt][2] * inv, o[nt][3] * inv);
            *(u32x2*)(yb + m * D + hq * 64 + 16 * nt + 4 * fq) = w; }
    }
    __syncthreads();
}
constexpr int SS_K = 0, SS_V = SW_BT + 16 * 132 * 4;
__device__ __forceinline__ void swa_sample_wg(CArgs& A, Frame& F, int L, int item) {
    const int b = item >> 1, kp = item & 1; const int tok0 = TP + b * 4;
    LAS bf16* Kl = (LAS bf16*)(F.lds + SS_K); LAS bf16* Vl = (LAS bf16*)(F.lds + SS_V); const LAS float* bt = (const LAS float*)(F.lds + SW_BT);
    const bf16* Ks = WSP(bf16, WS_KS); const bf16* Vs = WSP(bf16, WS_VS); const bf16* Qs = WSP(bf16, WS_QS); bf16* yb = WSP(bf16, WS_YB);
    const size_t so = ((size_t)L * 128 + b) * 32768 + kp * 128;
    const float* bk = A.in[5] + so; const float* bv = A.in[6] + so; float* dk = F.out + O_KS + so; float* dv = F.out + O_VS + so;
    const int fr = F.lane & 15, fq = F.lane >> 4, hq = 8 * kp + F.wave, kvl = F.wave >> 2;
    bf16x8 qf[2];
    { const bf16* qb = Qs + (size_t)(tok0 + (fr & 3)) * D + hq * 64 + 8 * fq; qf[0] = *(const bf16x8*)qb; qf[1] = *(const bf16x8*)(qb + 32); }
    f32x4 rk[8], rv[8];
#pragma unroll
    for (int i = 0; i < 8; ++i) { const int idx = F.tid + NT * i, key = idx >> 5, c4 = idx & 31; rk[i] = __builtin_nontemporal_load((const f32x4*)(bk + key * 256 + 4 * c4)); }
#pragma unroll
    for (int i = 0; i < 8; ++i) { const int idx = F.tid + NT * i, key = idx >> 5, c4 = idx & 31; rv[i] = __builtin_nontemporal_load((const f32x4*)(bv + key * 256 + 4 * c4)); }
    if (F.tid < 128) { const int t = F.tid & 63, jj = t >> 4, seg = t & 15; const bf16* src = (F.tid < 64 ? Ks : Vs) + (size_t)(tok0 + jj) * 256 + kp * 128 + 8 * seg;
        LAS bf16* dst = (F.tid < 64 ? Kl : Vl) + ((seg >> 3) * (F.tid < 64 ? 144 : 160) + 128 + jj) * 72 + 8 * (seg & 7);
        *(LAS u32x4*)dst = *(const u32x4*)src; }
    else { const int t = F.tid - 128;
        unsigned zz = 0u; asm volatile("" : "+v"(zz));
        for (int q = t; q < 504; q += NT - 128) { const int rr = q / 9, pc = q % 9; *(LAS u32x4*)(Vl + ((rr / 28) * 160 + 132 + (rr % 28)) * 72 + 8 * pc) = (u32x4){zz, zz, zz, zz}; } }
#pragma unroll
    for (int i = 0; i < 8; ++i) { const int idx = F.tid + NT * i, key = idx >> 5, c4 = idx & 31;
        if (key >= 4) __builtin_nontemporal_store(rk[i], (f32x4*)(dk + (key - 4) * 256 + 4 * c4));
        u32x2 w; w.x = pk2(rk[i][0], rk[i][1]); w.y = pk2(rk[i][2], rk[i][3]); *(LAS u32x2*)(Kl + ((c4 >> 4) * 144 + key) * 72 + 4 * (c4 & 15)) = w; }
#pragma unroll
    for (int i = 0; i < 8; ++i) { const int idx = F.tid + NT * i, key = idx >> 5, c4 = idx & 31;
        if (key >= 4) __builtin_nontemporal_store(rv[i], (f32x4*)(dv + (key - 4) * 256 + 4 * c4));
        u32x2 w; w.x = pk2(rv[i][0], rv[i][1]); w.y = pk2(rv[i][2], rv[i][3]); *(LAS u32x2*)(Vl + ((c4 >> 4) * 160 + key) * 72 + 4 * (c4 & 15)) = w; }
    __syncthreads();
    const float sink = A.in[16][L * 16 + hq]; const LAS bf16* Kh = Kl + kvl * 144 * 72; const unsigned vtb = lds_addr(F.lds) + SS_V + (unsigned)(kvl * 160 * 72 * 2);
    float sv[9][4]; float mx = -INFINITY;
#pragma unroll
    for (int st = 0; st < 9; ++st) {
        f32x4 acc = (f32x4){0.f, 0.f, 0.f, 0.f};
#pragma unroll
        for (int ks = 0; ks < 2; ++ks) { const bf16x8 kf = *(const LAS bf16x8*)(Kh + (16 * st + fr) * 72 + 32 * ks + 8 * fq); acc = __builtin_amdgcn_mfma_f32_16x16x32_bf16(kf, qf[ks], acc, 0, 0, 0); }
#pragma unroll
        for (int j = 0; j < 4; ++j) { const int srel = 16 * st + 4 * fq + j; const int dist = fr + 128 - srel;
            const bool valid = (srel >= fr) && (dist >= 0);
            sv[st][j] = valid ? acc[j] + bt[hq * 132 + (dist < 0 ? 0 : (dist > 128 ? 128 : dist))] : -INFINITY; mx = fmaxf(mx, sv[st][j]); }
    }
    mx = fmaxf(mx, bperm(mx, F.lane ^ 16)); mx = fmaxf(mx, bperm(mx, F.lane ^ 32)); mx = fmaxf(mx, sink);
    const float mxl = mx * LOG2E; float sum = 0.f;
#pragma unroll
    for (int st = 0; st < 9; ++st)
#pragma unroll
        for (int j = 0; j < 4; ++j) { const float p = __builtin_amdgcn_exp2f(__builtin_fmaf(sv[st][j], LOG2E, -mxl)); sv[st][j] = p; sum += p; }
    sum += bperm(sum, F.lane ^ 16); sum += bperm(sum, F.lane ^ 32);
    const float inv = 1.0f / (sum + __builtin_amdgcn_exp2f(__builtin_fmaf(sink, LOG2E, -mxl)));
    f32x4 o[4];
#pragma unroll
    for (int nt = 0; nt < 4; ++nt) o[nt] = (f32x4){0.f, 0.f, 0.f, 0.f};
#pragma unroll
    for (int k2 = 0; k2 < 5; ++k2) {
        u32x4 pw; pw.x = pk2(sv[2 * k2][0], sv[2 * k2][1]); pw.y = pk2(sv[2 * k2][2], sv[2 * k2][3]);
        if (k2 < 4) { pw.z = pk2(sv[2 * k2 + 1 > 8 ? 8 : 2 * k2 + 1][0], sv[2 * k2 + 1 > 8 ? 8 : 2 * k2 + 1][1]); pw.w = pk2(sv[2 * k2 + 1 > 8 ? 8 : 2 * k2 + 1][2], sv[2 * k2 + 1 > 8 ? 8 : 2 * k2 + 1][3]); } else { pw.z = 0u; pw.w = 0u; }
        const bf16x8 pf = __builtin_bit_cast(bf16x8, pw);
        { const int T0 = 32 * k2 + 4 * fq + ((F.lane & 15) >> 2); const unsigned a0 = vtb + (unsigned)((T0 * 72 + 4 * (F.lane & 3)) * 2);
          bf16x8 vf[4]; tr_frag4(a0, a0 + 16 * 72 * 2, 32u, vf);
#pragma unroll
          for (int nt = 0; nt < 4; ++nt) o[nt] = __builtin_amdgcn_mfma_f32_16x16x32_bf16(vf[nt], pf, o[nt], 0, 0, 0); }
    }
    if (fr < 4) {
#pragma unroll
        for (int nt = 0; nt < 4; ++nt) { u32x2 w; w.x = pk2(o[nt][0] * inv, o[nt][1] * inv); w.y = pk2(o[nt][2] * inv, o[nt][3] * inv);
            *(u32x2*)(yb + (size_t)(tok0 + fr) * D + hq * 64 + 16 * nt + 4 * fq) = w; } }
    __syncthreads();
}

constexpr int RW_STRIDE = 1032, RW_LO = 36 * RW_STRIDE * 2;
__device__ __forceinline__ void ln1_router_phase(CArgs& A, Frame& F, int L) {
    LAS bf16* Wh = (LAS bf16*)F.lds; LAS bf16* Wl = (LAS bf16*)(F.lds + RW_LO);
    { const u32x4* srcw = (const u32x4*)(F.ws + WS_RW);
#pragma unroll 6
      for (int i = F.tid; i < 2 * 36 * RW_STRIDE * 2 / 16; i += NT) *(LAS u32x4*)(F.lds + 16 * i) = srcw[i]; }
    if (F.tid < 32) F.LW[LW_CNT + F.tid] = 0u;
    const int rpw = (T + F.G - 1) / F.G, r0 = F.bid * rpw, r1 = (r0 + rpw < T) ? r0 + rpw : T;
    const float* g = A.in[17] + ((size_t)L * 3 + 0) * D; const float* bb = A.in[18] + ((size_t)L * 3 + 0) * D;
    const float* b_rg = A.in[20] + L * 4; const float* b_re = A.in[22] + L * 32;
    bf16* X = WSP(bf16, WS_X); int* asg = WSP(int, WS_ASG); float* gate = WSP(float, WS_GATE);
    { u32x4 na[2], nb[2]; const int mf = r0 + 2 * F.wave;
      if (mf < r1) { row_raw(X + (size_t)mf * D, F.lane, na); row_raw(X + (size_t)((mf + 1 < r1) ? mf + 1 : mf) * D, F.lane, nb); }
      for (int m = mf; m < r1; m += 2 * NW) { const int mb = (m + 1 < r1) ? m + 1 : m; f32x4 va[4], vb[4];
        row_unpack(na, va); row_unpack(nb, vb);
        { const int mn = m + 2 * NW; if (mn < r1) { row_raw(X + (size_t)mn * D, F.lane, na); row_raw(X + (size_t)((mn + 1 < r1) ? mn + 1 : mn) * D, F.lane, nb); } }
        row_ln(va, g, bb, F.lane); row_ln(vb, g, bb, F.lane);
        row_store_bf(X + (size_t)m * D, F.lane, va); row_store_bf(X + (size_t)mb * D, F.lane, vb); } }
    VM_WAIT(); __syncthreads();
    const int ntile = (r1 - r0 + 15) >> 4; const int fr = F.lane & 15, fq = F.lane >> 4;
    float* LG = WSP(float, WS_LG);
    for (int tile = F.wave; tile < ntile; tile += NW) {
        f32x4 lacc[3] = {(f32x4){0.f, 0.f, 0.f, 0.f}, (f32x4){0.f, 0.f, 0.f, 0.f}, (f32x4){0.f, 0.f, 0.f, 0.f}};
        const int trow = (r0 + 16 * tile + fr < r1) ? r0 + 16 * tile + fr : r1 - 1;
        const bf16* xr = X + (size_t)trow * D + 8 * fq;
        int orow[3];
#pragma unroll
        for (int nt = 0; nt < 3; ++nt) orow[nt] = ((16 * nt + fr < 36) ? 16 * nt + fr : 35) * RW_STRIDE + 8 * fq;
#pragma unroll 1
        for (int half = 0; half < 2; ++half) {
            bf16x8 af[16];
#pragma unroll
            for (int ks = 0; ks < 16; ++ks) af[ks] = *(const bf16x8*)(xr + 32 * (16 * half + ks));
#pragma unroll
            for (int ks = 0; ks < 16; ++ks)
#pragma unroll
                for (int nt = 0; nt < 3; ++nt) { const int off = orow[nt] + 32 * (16 * half + ks);
                    const bf16x8 bh = *(const LAS bf16x8*)(Wh + off), bl = *(const LAS bf16x8*)(Wl + off);
                    lacc[nt] = __builtin_amdgcn_mfma_f32_16x16x32_bf16(bh, af[ks], lacc[nt], 0, 0, 0);
                    lacc[nt] = __builtin_amdgcn_mfma_f32_16x16x32_bf16(bl, af[ks], lacc[nt], 0, 0, 0); } }
        if (r0 + 16 * tile + fr < r1) {
#pragma unroll
            for (int nt = 0; nt < 3; ++nt) *(f32x4*)(LG + (size_t)trow * 48 + 16 * nt + 4 * fq) = lacc[nt]; }
    }
    VM_WAIT(); __syncthreads();
    for (int m = r0 + F.tid; m < r1; m += NT) { const float* lr = LG + (size_t)m * 48;
        float gl[4]; int gi = 0;
        { const f32x4 x = *(const f32x4*)lr; gl[0] = x[0] + b_rg[0]; gl[1] = x[1] + b_rg[1]; gl[2] = x[2] + b_rg[2]; gl[3] = x[3] + b_rg[3]; }
        float gmax = gl[0];
#pragma unroll
        for (int c = 1; c < 4; ++c) if (gl[c] > gmax) { gmax = gl[c]; gi = c; }
        float gs = 0.f;
#pragma unroll
        for (int c = 0; c < 4; ++c) gs += expf(gl[c] - gmax);
        const float gw_ = 1.0f / gs;
        float el[8];
        { const f32x4 x = *(const f32x4*)(lr + 4 + 8 * gi), y = *(const f32x4*)(lr + 8 + 8 * gi); const f32x4 bx = *(const f32x4*)(b_re + 8 * gi), by = *(const f32x4*)(b_re + 8 * gi + 4);
          el[0] = x[0] + bx[0]; el[1] = x[1] + bx[1]; el[2] = x[2] + bx[2]; el[3] = x[3] + bx[3]; el[4] = y[0] + by[0]; el[5] = y[1] + by[1]; el[6] = y[2] + by[2]; el[7] = y[3] + by[3]; }
        int i1 = 0; float l1 = el[0];
#pragma unroll
        for (int i = 1; i < 8; ++i) if (el[i] > l1) { l1 = el[i]; i1 = i; }
        int i2 = -1; float l2v = -INFINITY;
#pragma unroll
        for (int i = 0; i < 8; ++i) if (i != i1 && el[i] > l2v) { l2v = el[i]; i2 = i; }
        const float e2 = expf(l2v - l1), r = 1.0f / (1.0f + e2);
        const int ea = gi * 8 + i1, eb = gi * 8 + i2;
        const unsigned ra = __hip_atomic_fetch_add((LAS unsigned*)&F.LW[LW_CNT + ea], 1u, __ATOMIC_RELAXED, __HIP_MEMORY_SCOPE_WORKGROUP);
        const unsigned rb = __hip_atomic_fetch_add((LAS unsigned*)&F.LW[LW_CNT + eb], 1u, __ATOMIC_RELAXED, __HIP_MEMORY_SCOPE_WORKGROUP);
        asg[2 * m] = (ea << 24) | (int)ra; asg[2 * m + 1] = (eb << 24) | (int)rb; gate[2 * m] = gw_ * r; gate[2 * m + 1] = gw_ * e2 * r; }
    VM_WAIT(); __syncthreads();
    if (F.tid < 32) { const unsigned c = F.LW[LW_CNT + F.tid]; F.LW[LW_BASE + F.tid] = __hip_atomic_fetch_add(F.ctl + CW_CNT + (L * 32 + F.tid) * 64, c, __ATOMIC_RELAXED, __HIP_MEMORY_SCOPE_AGENT); }
    __syncthreads();
    { bf16* Xg = WSP(bf16, WS_XG); int* slot = WSP(int, WS_SLOT);
      int nag[4]; u32x4 nwa[2], nwb[2];
#define LN1E_LOAD(mq_) do { const int ma_ = (mq_), mb_ = (ma_ + 1 < r1) ? ma_ + 1 : ma_; nag[0] = asg[2 * ma_]; nag[1] = asg[2 * ma_ + 1]; nag[2] = asg[2 * mb_]; nag[3] = asg[2 * mb_ + 1]; \
          row_raw(X + (size_t)ma_ * D, F.lane, nwa); row_raw(X + (size_t)mb_ * D, F.lane, nwb); } while (0)
      if (r0 + 2 * F.wave < r1) LN1E_LOAD(r0 + 2 * F.wave);
      for (int m = r0 + 2 * F.wave; m < r1; m += 2 * NW) { const int mb = (m + 1 < r1) ? m + 1 : m;
        int ag[4]; u32x4 wa[2], wb[2];
#pragma unroll
        for (int q = 0; q < 4; ++q) ag[q] = nag[q];
        wa[0] = nwa[0]; wa[1] = nwa[1]; wb[0] = nwb[0]; wb[1] = nwb[1];
        if (m + 2 * NW < r1) LN1E_LOAD(m + 2 * NW);
        int sl[4];
#pragma unroll
        for (int q = 0; q < 4; ++q) { const int e = (int)((unsigned)ag[q] >> 24), rk = (ag[q] & 0xffffff) + (int)F.LW[LW_BASE + e]; ag[q] = (e << 24) | rk; sl[q] = rk < ECAP ? e * ECAP + rk : -1; }
        if (F.lane == 0) { asg[2 * m] = ag[0]; asg[2 * m + 1] = ag[1]; slot[2 * m] = sl[0]; slot[2 * m + 1] = sl[1];
            if (mb != m) { asg[2 * mb] = ag[2]; asg[2 * mb + 1] = ag[3]; slot[2 * mb] = sl[2]; slot[2 * mb + 1] = sl[3]; } }
#pragma unroll
        for (int j = 0; j < 2; ++j) {
            if (sl[0] >= 0) *(u32x4*)(Xg + (size_t)sl[0] * D + 8 * F.lane + 512 * j) = wa[j]; if (sl[1] >= 0) *(u32x4*)(Xg + (size_t)sl[1] * D + 8 * F.lane + 512 * j) = wa[j];
            if (sl[2] >= 0) *(u32x4*)(Xg + (size_t)sl[2] * D + 8 * F.lane + 512 * j) = wb[j]; if (sl[3] >= 0) *(u32x4*)(Xg + (size_t)sl[3] * D + 8 * F.lane + 512 * j) = wb[j]; }
      }
#undef LN1E_LOAD
    }
}
__device__ __forceinline__ void moe_tables(Frame& F, int L) {
    if (F.wave == 0) {
        const int e = F.lane; unsigned cnt = 0u;
        if (e < 32) cnt = __hip_atomic_load(F.ctl + CW_CNT + (L * 32 + e) * 64, __ATOMIC_RELAXED, __HIP_MEMORY_SCOPE_AGENT);
        const unsigned ovf = (__builtin_amdgcn_ballot_w64(cnt > (unsigned)ECAP) != 0ull) ? 1u : 0u;
        const unsigned np = (cnt + 255u) >> 8; int incl = (int)np;
#pragma unroll
        for (int o = 1; o < 32; o <<= 1) { const int t = __builtin_amdgcn_ds_bpermute((e - o) << 2, incl); if (e >= o) incl += t; }
        const unsigned excl = (unsigned)incl - np;
        if (e < 32) { F.LW[LW_FCNT + e] = cnt; F.LW[LW_PST + e] = excl * 256u;
#pragma unroll 1
            for (unsigned q = 0; q < np; ++q) F.LW[LW_PANE + excl + q] = ((unsigned)e << 16) | (ovf ? excl + q : (unsigned)e * 8u + q); }
        if (e == 31) { F.LW[LW_PST + 32] = (unsigned)incl * 256u; F.LW[LW_NP] = (unsigned)incl; F.LW[LW_OVF] = ovf; }
    }
    __syncthreads();
}
__device__ __forceinline__ void gather_exact(Frame& F) {
    const bf16* X = WSP(bf16, WS_X); bf16* Xg = WSP(bf16, WS_XG); const int* asg = WSP(int, WS_ASG); int* slot = WSP(int, WS_SLOT);
    for (int m = F.gw; m < T; m += F.NGW) {
        const int a0 = asg[2 * m], a1 = asg[2 * m + 1];
        const int s0 = (int)F.LW[LW_PST + ((unsigned)a0 >> 24)] + (a0 & 0xffffff), s1 = (int)F.LW[LW_PST + ((unsigned)a1 >> 24)] + (a1 & 0xffffff);
        if (F.lane == 0) { slot[2 * m] = s0; slot[2 * m + 1] = s1; }
#pragma unroll
        for (int j = 0; j < 4; ++j) { const u32x2 w = *(const u32x2*)(X + (size_t)m * D + 4 * F.lane + 256 * j);
            *(u32x2*)(Xg + (size_t)s0 * D + 4 * F.lane + 256 * j) = w; *(u32x2*)(Xg + (size_t)s1 * D + 4 * F.lane + 256 * j) = w; }
    }
}
__device__ __forceinline__ void ln2_phase(CArgs& A, Frame& F, int L) {
    const float* g = A.in[17] + ((size_t)L * 3 + 1) * D; const float* bb = A.in[18] + ((size_t)L * 3 + 1) * D;
    bf16* X = WSP(bf16, WS_X); const bf16* YS = WSP(bf16, WS_YS); const int* slot = WSP(int, WS_SLOT); const float* gate = WSP(float, WS_GATE);
    int m0, m1; row_range(F, m0, m1);
    for (int c0 = m0; c0 < m1; c0 += 32) { const int c1 = (c0 + 32 < m1) ? c0 + 32 : m1;
        int slv = 0; float gtv = 0.f;
        if (F.lane < 2 * (c1 - c0)) { slv = slot[2 * c0 + F.lane]; gtv = gate[2 * c0 + F.lane]; }
        u32x4 nx[2][3][2];
#define LN2_LOAD(mq_) do { _Pragma("unroll") for (int r = 0; r < 2; ++r) { const int mm_ = ((mq_) + r < c1) ? (mq_) + r : c1 - 1; const int i_ = 2 * (mm_ - c0); \
            const int s0_ = __builtin_amdgcn_readlane(slv, i_), s1_ = __builtin_amdgcn_readlane(slv, i_ + 1); \
            row_raw(X + (size_t)mm_ * D, F.lane, nx[r][0]); row_raw(YS + (size_t)s0_ * D, F.lane, nx[r][1]); row_raw(YS + (size_t)s1_ * D, F.lane, nx[r][2]); } } while (0)
        LN2_LOAD(c0);
        for (int m = c0; m < c1; m += 2) {
            u32x4 cur[2][3][2];
#pragma unroll
            for (int r = 0; r < 2; ++r)
#pragma unroll
                for (int k = 0; k < 3; ++k) { cur[r][k][0] = nx[r][k][0]; cur[r][k][1] = nx[r][k][1]; }
            if (m + 2 < c1) LN2_LOAD(m + 2);
#pragma unroll
            for (int r = 0; r < 2; ++r) { const int mm = (m + r < c1) ? m + r : c1 - 1; const int i_ = 2 * (mm - c0);
                const float g0 = __builtin_bit_cast(float, __builtin_amdgcn_readlane(__builtin_bit_cast(int, gtv), i_)), g1 = __builtin_bit_cast(float, __builtin_amdgcn_readlane(__builtin_bit_cast(int, gtv), i_ + 1));
                f32x4 v[4]; row_unpack(cur[r][0], v);
#pragma unroll
                for (int j2 = 0; j2 < 2; ++j2) { const unsigned a0[4] = {cur[r][1][j2].x, cur[r][1][j2].y, cur[r][1][j2].z, cur[r][1][j2].w}, a1[4] = {cur[r][2][j2].x, cur[r][2][j2].y, cur[r][2][j2].z, cur[r][2][j2].w};
#pragma unroll
                    for (int q = 0; q < 4; ++q) { f32x4& vv = v[2 * j2 + (q >> 1)]; const int i0 = 2 * (q & 1);
                        vv[i0] = vv[i0] * DN_ALPHA + (g0 * bflo(a0[q]) + g1 * bflo(a1[q])); vv[i0 + 1] = vv[i0 + 1] * DN_ALPHA + (g0 * bfhi(a0[q]) + g1 * bfhi(a1[q])); } }
                row_ln(v, g, bb, F.lane);
                row_store_bf(X + (size_t)mm * D, F.lane, v); }
        }
#undef LN2_LOAD
    }
}

constexpr int PH_PER_LAYER = 11, N_PHASES = 1 + DEPTH * PH_PER_LAYER;
__global__ void __launch_bounds__(NT, 2) fwd(const Args args) {
    extern __shared__ __attribute__((aligned(16))) unsigned char lds_raw[];
    Frame F0;
    F0.lds = (LAS unsigned char*)lds_raw; F0.LW = (volatile LAS unsigned*)(F0.lds + LDSCTL_OFF);
    F0.tid = threadIdx.x; F0.lane = F0.tid & 63; F0.wave = __builtin_amdgcn_readfirstlane(F0.tid >> 6); F0.G = gridDim.x; F0.bid = blockIdx.x; F0.gw = blockIdx.x * NW + F0.wave; F0.NGW = F0.G * NW;
    F0.out = nullptr; F0.ws = nullptr; F0.ctl = nullptr;
    for (int u = F0.tid; u < (LDS_BYTES - LDSCTL_OFF) / 4; u += NT) F0.LW[u] = 0u;
    __syncthreads();
    const int lo = args.ph_lo, hi = args.ph_hi;
    const bool multi = (hi - lo) > 1;
    XcdBarrier bar; bar.bar = (unsigned*)(args.ws + WS_CTL) + CW_BAR; bar.x = 0; bar.st = F0.LW + LW_XB;
    if (multi) bar = xcd_barrier_post((unsigned*)(args.ws + WS_CTL) + CW_BAR, F0.LW + LW_XB);
#ifdef PH_ONLY
#define IN(k) (((k) == 0 ? 0 : (((k) - 1) % PH_PER_LAYER) + 1) == PH_ONLY && lo <= (k) && (k) < hi)
#else
#define IN(k) (lo <= (k) && (k) < hi)
#endif
#define SEAM(k) do { if (IN(k) && IN((k) + 1)) { XcdBarrier b_ = bar; asm volatile("" : "+s"(b_.bar)); xcd_barrier(b_); } } while (0)
#define REPEAT(k) for (int rep_ = 0; rep_ < ((k) == REP_SEL ? REP_N : 1); ++rep_)
#define PHASE_BEGIN CArgs* ap_ = (CArgs*)__builtin_amdgcn_kernarg_segment_ptr(); int L = Lrt; asm volatile("" : "+s"(ap_), "+s"(L)); CArgs& A = *ap_; Frame F = F0; F.ws = A.ws; F.out = A.out; F.ctl = (unsigned*)(F.ws + WS_CTL); { unsigned z_ = 0u; asm volatile("" : "+s"(z_)); int l_ = (int)__builtin_amdgcn_mbcnt_hi(~0u, __builtin_amdgcn_mbcnt_lo(~0u, z_)), w_ = F0.wave, b_ = F0.bid; asm volatile("" : "+v"(l_), "+s"(w_), "+s"(b_)); F.tid = w_ * 64 + l_; F.bid = b_; F.lane = l_; F.wave = w_; F.gw = b_ * NW + w_; }

    if (IN(0)) {
        const int Lrt = 0; PHASE_BEGIN
        stage_wig(A, F, 0); __syncthreads();
        { int m0, m1; row_range(F, m0, m1);
          for (int m = m0; m < m1; m += 2) { const int mb = (m + 1 < m1) ? m + 1 : m; f32x4 va[4], vb[4];
              row_load(m < TP ? A.in[0] + (size_t)m * D : A.in[1] + (size_t)(m - TP) * D, F.lane, va); row_load(mb < TP ? A.in[0] + (size_t)mb * D : A.in[1] + (size_t)(mb - TP) * D, F.lane, vb);
              row_finalize(A, F, m, va, 0); row_finalize(A, F, mb, vb, 0); } }
        convert_layer(A, F, 0, 0);
    }
    SEAM(0);
    for (int Lrt = 0; Lrt < DEPTH; ++Lrt) {
        const int pb = 1 + Lrt * PH_PER_LAYER;
        if (IN(pb + 0)) REPEAT(1) { PHASE_BEGIN
            pg8::StaticOrder S; S.init(T / 256, NIN / 256, F.G, F.bid);
            EpiIn E{F.ws, F.out, A.in[10] + (size_t)L * DIN, L};
            pg8::gemm_phase(F.tid, F.lds, WSP(bf16, WS_X), WSW(bf16, WS_WIN, L), D, S, E);
            if (L + 1 < DEPTH) { REFRESH_LANE(F); const int rem = ((T / 256) * (NIN / 256)) % F.G;
                if (rem == 0 || F.bid >= rem) convert_range(A, F, L + 1, CV_D, CV_I, rem == 0 ? F.G : F.G - rem, rem == 0 ? F.bid : F.bid - rem); }
        }
        SEAM(pb + 0);
        if (IN(pb + 1)) REPEAT(2) { PHASE_BEGIN
            swa_build_bias(A, F); __syncthreads();
            for (int it = F.bid; it < 512; it += F.G) swa_item(A, F, L, it);
            for (int it = F.bid; it < 256; it += F.G) mseq_item(F, L, it);
            for (int it = F.bid; it < 512; it += F.G) ms_item(A, F, L, it);
            for (int it = F.bid; it < 256; it += F.G) swa_sample_wg(A, F, L, it);
        }
        SEAM(pb + 1);
        if (IN(pb + 2)) REPEAT(4) { PHASE_BEGIN for (int it = F.bid; it < 1024; it += F.G) m4_item(A, F, L, it); }
        SEAM(pb + 2);
        if (IN(pb + 3)) REPEAT(5) { PHASE_BEGIN
            pg8::PairOrder S; S.so.init(TP / 256, 4, F.G, F.bid);
            EpiAB E{EpiF<0>{nullptr, WSP(float, WS_MIXA), WSP(bf16, WS_GA), nullptr, nullptr}, EpiF<1>{nullptr, WSP(float, WS_MIXA), WSP(bf16, WS_GB), WSP(bf16, WS_U), nullptr}};
            pg8::gemm_phase(F.tid, F.lds, WSP(bf16, WS_YA), WSW(bf16, WS_WA, L), D, S, E, WSP(bf16, WS_YB), WSW(bf16, WS_WB, L));
            small_gemm(F, WSP(bf16, WS_YA), WSW(bf16, WS_WA, L), D, E.e0); small_gemm(F, WSP(bf16, WS_YB), WSW(bf16, WS_WB, L), D, E.e1);
        }
        SEAM(pb + 3);
        if (IN(pb + 4)) { PHASE_BEGIN
            pg8::StaticOrder S; S.init(TP / 256, 4, F.G, F.bid);
            EpiF<2> E{WSP(bf16, WS_X), nullptr, nullptr, nullptr, nullptr}; pg8::gemm_phase(F.tid, F.lds, WSP(bf16, WS_U), WSW(bf16, WS_WOUT, L), D, S, E); small_gemm(F, WSP(bf16, WS_U), WSW(bf16, WS_WOUT, L), D, E);
        }
        SEAM(pb + 4);
        if (IN(pb + 5)) { PHASE_BEGIN ln1_router_phase(A, F, L); }
        SEAM(pb + 5);
        if (IN(pb + 6)) REPEAT(9) { PHASE_BEGIN
            moe_tables(F, L);
            if (__builtin_amdgcn_readfirstlane((int)F.LW[LW_OVF]) != 0) { gather_exact(F); XcdBarrier b_ = bar; asm volatile("" : "+s"(b_.bar)); xcd_barrier(b_); }
            asm volatile("" : "+v"(F.tid));
            pg8::MoeOrder S{(const volatile LAS int*)(F.LW + LW_PANE), __builtin_amdgcn_readfirstlane((int)F.LW[LW_NP]), F.G, F.bid};
            EpiGU E{WSP(bf16, WS_H)}; pg8::gemm_phase(F.tid, F.lds, WSP(bf16, WS_XG), WSW(bf16, WS_WGU, L), D, S, E);
            if (L + 1 < DEPTH) { REFRESH_LANE(F); const int rem = (__builtin_amdgcn_readfirstlane((int)F.LW[LW_NP]) * 4) % F.G;
                if (rem == 0 || F.bid >= rem) convert_range(A, F, L + 1, 0, CV_G, rem == 0 ? F.G : F.G - rem, rem == 0 ? F.bid : F.bid - rem); }
        }
        SEAM(pb + 6);
        if (IN(pb + 7)) REPEAT(10) { PHASE_BEGIN
            moe_tables(F, L); asm volatile("" : "+v"(F.tid));
            pg8::MoeOrder S{(const volatile LAS int*)(F.LW + LW_PANE), __builtin_amdgcn_readfirstlane((int)F.LW[LW_NP]), F.G, F.bid};
            EpiDN E{WSP(bf16, WS_YS)}; pg8::gemm_phase(F.tid, F.lds, WSP(bf16, WS_H), WSW(bf16, WS_WD, L), DEXP, S, E);
            { const int nu = __builtin_amdgcn_readfirstlane((int)F.LW[LW_NP]) * 4, rem = nu % F.G; asm volatile("" : "+v"(F.tid));
              if (rem == 0 || F.bid >= rem) { pg8::SubsetOrder S2{(T / 256) * 4, rem == 0 ? F.G : F.G - rem, rem == 0 ? F.bid : F.bid - rem};
                  EpiF<3> E2{nullptr, WSP(float, WS_T2), nullptr, nullptr, nullptr}; pg8::gemm_phase(F.tid, F.lds, WSP(bf16, WS_PB), WSW(bf16, WS_WPP, L), DPLE, S2, E2);
                  if (L + 1 < DEPTH) { REFRESH_LANE(F); convert_range(A, F, L + 1, CV_G, CV_D, rem == 0 ? F.G : F.G - rem, rem == 0 ? F.bid : F.bid - rem); } } }
        }
        SEAM(pb + 7);
        if (IN(pb + 8)) { PHASE_BEGIN ln2_phase(A, F, L); }
        SEAM(pb + 8);
        if (IN(pb + 9)) { PHASE_BEGIN
            pg8::StaticOrder S; S.init(TP / 256, 4, F.G, F.bid);
            { EpiF<4> E{WSP(bf16, WS_X), WSP(float, WS_T2), nullptr, nullptr, WSP(bf16, WS_XB)}; pg8::gemm_phase(F.tid, F.lds, WSP(bf16, WS_X), WSW(bf16, WS_WPG, L), D, S, E); small_gemm(F, WSP(bf16, WS_X), WSW(bf16, WS_WPG, L), D, E); }
        }
        SEAM(pb + 9);
        if (IN(pb + 10)) { PHASE_BEGIN
            const float* g = A.in[17] + ((size_t)L * 3 + 2) * D; const float* bb = A.in[18] + ((size_t)L * 3 + 2) * D; const bf16* X = WSP(bf16, WS_XB);
            if (L + 1 < DEPTH) { stage_wig(A, F, L + 1); __syncthreads(); }
            int m0, m1; row_range(F, m0, m1);
            for (int m = m0; m < m1; m += 4) { u32x4 r[4][2];
#pragma unroll
                for (int q = 0; q < 4; ++q) { const int mm = (m + q < m1) ? m + q : m1 - 1; row_raw(X + (size_t)mm * D, F.lane, r[q]); }
#pragma unroll
                for (int q = 0; q < 4; ++q) if (m + q < m1) { f32x4 v[4]; row_unpack(r[q], v); row_ln(v, g, bb, F.lane);
                    if (L + 1 < DEPTH) row_finalize(A, F, m + q, v, L + 1);
                    else {
#pragma unroll
                        for (int j = 0; j < 4; ++j) *(f32x4*)(F.out + O_Y + (size_t)(m + q) * D + RCOL(F.lane, j)) = v[j]; } } }
            if (L + 1 < DEPTH) convert_layer(A, F, L + 1, CV_I);
        }
        SEAM(pb + 10);
    }
#undef IN
#undef SEAM
}

extern "C" void kernel_launch(void* const* d_in, const int* in_sizes, int n_in, void* d_out, int out_size, void* d_ws, size_t ws_size, hipStream_t stream) {
    static int grid = 0;
    if (grid == 0) {
        if (n_in != 28 || (size_t)out_size != O_END || ws_size < WS_END) { fprintf(stderr, "kernel_launch: unexpected shapes: n_in %d out %d ws %zu (need %zu)\n", n_in, out_size, ws_size, (size_t)WS_END); grid = -1; return; }
        int dev = 0, cus = 0, per_cu = 0;
        if (hipGetDevice(&dev) != hipSuccess || hipDeviceGetAttribute(&cus, hipDeviceAttributeMultiprocessorCount, dev) != hipSuccess) { grid = -1; return; }
        if (hipFuncSetAttribute((const void*)fwd, hipFuncAttributeMaxDynamicSharedMemorySize, LDS_BYTES) != hipSuccess) { fprintf(stderr, "kernel_launch: hipFuncSetAttribute failed\n"); grid = -1; return; }
        if (hipOccupancyMaxActiveBlocksPerMultiprocessor(&per_cu, (const void*)fwd, NT, LDS_BYTES) != hipSuccess || per_cu < 1) fprintf(stderr, "kernel_launch: occupancy query says %d\n", per_cu);
        (void)hipGetLastError();
        grid = cus;
    }
    if (grid < 0) return;
    (void)hipMemsetAsync((char*)d_ws + WS_CTL, 0, 128u << 10, stream);
    Args a{};
    for (int i = 0; i < 28; ++i) a.in[i] = (const float*)d_in[i];
    a.out = (float*)d_out; a.ws = (unsigned char*)d_ws;
#if MK_ONE_LAUNCH
    a.ph_lo = 0; a.ph_hi = N_PHASES;
    hipLaunchKernelGGL(fwd, dim3(grid), dim3(NT), LDS_BYTES, stream, a);
#else
    for (int p = 0; p < N_PHASES; ++p) { a.ph_lo = p; a.ph_hi = p + 1; hipLaunchKernelGGL(fwd, dim3(grid), dim3(NT), LDS_BYTES, stream, a); }
#endif
}
```

```cpp
#include <hip/hip_runtime.h>
#include <cstdio>
#include <cstdint>

#ifndef REP_SEL
#define REP_SEL -1
#define REP_N 1
#endif
#ifndef MK_ONE_LAUNCH
#define MK_ONE_LAUNCH 1
#endif

#define LAS __attribute__((address_space(3)))
#define GAS __attribute__((address_space(1)))
typedef unsigned short bf16;
typedef short bf16x8 __attribute__((ext_vector_type(8)));
typedef short bf16x4 __attribute__((ext_vector_type(4)));
typedef float f32x4 __attribute__((ext_vector_type(4)));
typedef float f32x2 __attribute__((ext_vector_type(2)));
typedef unsigned u32x4 __attribute__((ext_vector_type(4)));
typedef unsigned u32x2 __attribute__((ext_vector_type(2)));

constexpr int D = 1024, TP = 16384, TS = 512, T = TP + TS, DEPTH = 4, SEQ = 2048;
constexpr int DIN = 6664, NIN = 6656;
constexpr int NEXP = 32, DEXP = 512, DPLE = 256;
constexpr int ECAP = 2048, PMAX = NEXP * ECAP;
constexpr float LN_EPS = 1e-5f;
constexpr float DN_ALPHA = 1.6817928305074292f;
constexpr int NW = 8, NT = 512;

constexpr size_t O_Y = 0, O_CP = 17301504, O_NP = 21495808, O_MP = 21512192, O_KP = 21512320, O_VP = 22560896,
                 O_CS = 23609472, O_NS = 90718336, O_MS = 90980480, O_KS = 90982528, O_VS = 107759744, O_END = 124536960;

constexpr size_t al256(size_t x) { return (x + 255) & ~(size_t)255; }
constexpr size_t WS_CTL = 0, CTL_BYTES = 1u << 20;
constexpr size_t WS_WIN = CTL_BYTES;
constexpr size_t WS_WA = WS_WIN + (size_t)NIN * D * 2;
constexpr size_t WS_WB = WS_WA + (size_t)D * D * 2;
constexpr size_t WS_WOUT = WS_WB + (size_t)D * D * 2;
constexpr size_t WS_WPG = WS_WOUT + (size_t)D * D * 2;
constexpr size_t WS_WPP = WS_WPG + (size_t)D * D * 2;
constexpr size_t WS_WGU = WS_WPP + (size_t)D * DPLE * 2;
constexpr size_t WS_WD = WS_WGU + (size_t)NEXP * D * D * 2;
constexpr size_t WS_X = WS_WD + (size_t)NEXP * D * DEXP * 2;
constexpr size_t WS_XB = WS_X + (size_t)T * D * 4;
constexpr size_t WS_QM = WS_XB + (size_t)T * D * 2;
constexpr size_t WS_KM = WS_QM + (size_t)T * 512 * 2;
constexpr size_t WS_VM = WS_KM + (size_t)T * 512 * 2;
constexpr size_t WS_OG = WS_VM + (size_t)T * D * 2;
constexpr size_t WS_QS = WS_OG + (size_t)T * D * 2;
constexpr size_t WS_KS = WS_QS + (size_t)T * D * 2;
constexpr size_t WS_VS = WS_KS + (size_t)T * 256 * 2;
constexpr size_t WS_GA = WS_VS + (size_t)T * 256 * 2;
constexpr size_t WS_GB = WS_GA + (size_t)T * D * 2;
constexpr size_t WS_IGFG = WS_GB + (size_t)T * D * 2;
constexpr size_t WS_YA = al256(WS_IGFG + (size_t)T * 8 * 4);
constexpr size_t WS_YB = WS_YA + (size_t)T * D * 2;
constexpr size_t WS_MIXA = WS_YB + (size_t)T * D * 2;
constexpr size_t WS_U = WS_MIXA + (size_t)T * D * 4;
constexpr size_t WS_XG = WS_U + (size_t)T * D * 2;
constexpr size_t WS_H = WS_XG + (size_t)PMAX * D * 2;
constexpr size_t WS_YS = WS_H + (size_t)PMAX * DEXP * 2;
constexpr size_t WS_PB = WS_YS + (size_t)PMAX * D * 2;
constexpr size_t WS_T2 = WS_PB + (size_t)T * DPLE * 2;
constexpr size_t WS_CC = WS_T2 + (size_t)T * D * 2;
constexpr size_t WS_ASG = WS_CC + (size_t)1024 * 32768 * 2;
constexpr size_t WS_GATE = WS_ASG + (size_t)T * 2 * 4;
constexpr size_t WS_SLOT = WS_GATE + (size_t)T * 2 * 4;
constexpr size_t WS_BEND = WS_SLOT + (size_t)T * 2 * 4;
constexpr size_t WS_GMX = WS_BEND + 4096;
constexpr size_t WS_MC = WS_GMX + 4096;
constexpr size_t WS_DN = WS_MC + 4096;
constexpr size_t WS_NC = WS_DN + (size_t)1024 * 128 * 4;
constexpr size_t WS_W2 = al256(WS_NC + (size_t)1024 * 128 * 4);
constexpr size_t WSET_SHIFT = WS_W2 - WS_WIN;
constexpr size_t WS_RW = al256(WS_W2 + (WS_X - WS_WIN));
constexpr size_t WS_LG = al256(WS_RW + 149504);
constexpr size_t WS_END = WS_LG + (size_t)T * 48 * 4;

constexpr int CW_BAR = 4096;
constexpr int CW_CNT = 16384;

constexpr int LDS_BYTES = 157696;
constexpr int LDSCTL_OFF = 153600;
constexpr int LW_CNT = 0, LW_BASE = 32, LW_FCNT = 64, LW_PST = 96, LW_NP = 129, LW_OVF = 130, LW_XB = 132, LW_PANE = 160;

__device__ __forceinline__ unsigned f2bf(float f) { unsigned u = __float_as_uint(f); return (u + 0x7fffu + ((u >> 16) & 1u)) >> 16; }
__device__ __forceinline__ float bf2f(unsigned b) { return __uint_as_float(b << 16); }
__device__ __forceinline__ float bflo(unsigned w) { return __uint_as_float(w << 16); }
__device__ __forceinline__ float bfhi(unsigned w) { return __uint_as_float(w & 0xffff0000u); }
__device__ __forceinline__ unsigned pk2(float lo, float hi) { unsigned r; asm volatile("v_cvt_pk_bf16_f32 %0, %1, %2" : "=v"(r) : "v"(lo), "v"(hi)); return r; }
template <int CTRL, int ROWMASK> __device__ __forceinline__ float dppf(float v) { return __builtin_bit_cast(float, __builtin_amdgcn_update_dpp(0, __builtin_bit_cast(int, v), CTRL, ROWMASK, 0xf, false)); }
__device__ __forceinline__ float dpp_sum63(float v) {
    v += dppf<0xB1, 0xf>(v); v += dppf<0x4E, 0xf>(v); v += dppf<0x141, 0xf>(v); v += dppf<0x140, 0xf>(v);
    v += dppf<0x142, 0xa>(v); v += dppf<0x143, 0xc>(v); return v;
}
template <int CTRL, int ROWMASK> __device__ __forceinline__ float dppm(float v) { return __builtin_bit_cast(float, __builtin_amdgcn_update_dpp(__builtin_bit_cast(int, v), __builtin_bit_cast(int, v), CTRL, ROWMASK, 0xf, false)); }
__device__ __forceinline__ float rdlane(float v, int l) { return __builtin_bit_cast(float, __builtin_amdgcn_readlane(__builtin_bit_cast(int, v), l)); }
__device__ __forceinline__ float wave_sum(float v) { return rdlane(dpp_sum63(v), 63); }
__device__ __forceinline__ float wave_max(float v) {
    v = fmaxf(v, dppm<0xB1, 0xf>(v)); v = fmaxf(v, dppm<0x4E, 0xf>(v)); v = fmaxf(v, dppm<0x141, 0xf>(v)); v = fmaxf(v, dppm<0x140, 0xf>(v));
    v = fmaxf(v, dppm<0x142, 0xa>(v)); v = fmaxf(v, dppm<0x143, 0xc>(v)); return rdlane(v, 63);
}
__device__ __forceinline__ float bperm(float v, int srclane) { return __builtin_bit_cast(float, __builtin_amdgcn_ds_bpermute(srclane << 2, __builtin_bit_cast(int, v))); }
constexpr float LOG2E = 1.4426950408889634f;
__device__ __forceinline__ float sigmoid_fast(float x) { return __builtin_amdgcn_rcpf(1.0f + __expf(-x)); }
__device__ __forceinline__ float log_sigmoid(float x) { return fminf(x, 0.f) - log1pf(expf(-fabsf(x))); }
typedef short s16x4 __attribute__((ext_vector_type(4)));
__device__ __forceinline__ s16x4 tr_rd(unsigned a) { return __builtin_amdgcn_ds_read_tr16_b64_v4i16((LAS s16x4*)(__UINTPTR_TYPE__)a); }
__device__ __forceinline__ bf16x8 tr_frag(unsigned a0, unsigned a1) { const s16x4 r0 = tr_rd(a0), r1 = tr_rd(a1); return (bf16x8){r0[0], r0[1], r0[2], r0[3], r1[0], r1[1], r1[2], r1[3]}; }
__device__ __forceinline__ void tr_frag4(unsigned a0, unsigned a1, unsigned step, bf16x8 (&f)[4]) {
#pragma unroll
    for (int i = 0; i < 4; ++i) f[i] = tr_frag(a0 + i * step, a1 + i * step); }
__device__ __forceinline__ unsigned lds_addr(LAS void* p) { return (unsigned)(__UINTPTR_TYPE__)p; }
#define LDS_WAIT() asm volatile("s_waitcnt lgkmcnt(0)" ::: "memory")
#define VM_WAIT() asm volatile("s_waitcnt vmcnt(0)" ::: "memory")

__device__ const unsigned char RELB[132] = {0, 1, 2, 3, 4, 5, 6, 7, 8, 9, 10, 11, 12, 13, 14, 15, 16, 16, 16, 17, 17, 18, 18, 18, 19, 19, 19, 20, 20, 20, 20, 21, 21, 21, 21, 22, 22, 22, 22, 22, 23, 23, 23, 23, 23, 23, 24, 24, 24, 24, 24, 24, 25, 25, 25, 25, 25, 25, 25, 26, 26, 26, 26, 26, 26, 26, 26, 27, 27, 27, 27, 27, 27, 27, 27, 27, 27, 28, 28, 28, 28, 28, 28, 28, 28, 28, 28, 29, 29, 29, 29, 29, 29, 29, 29, 29, 29, 29, 29, 30, 30, 30, 30, 30, 30, 30, 30, 30, 30, 30, 30, 30, 30, 31, 31, 31, 31, 31, 31, 31, 31, 31, 31, 31, 31, 31, 31, 31, 31, 31, 31, 31};

#define XB_TMO      128
#define XB_XCNT(j)  (256  + 64 * (j))
#define XB_XSUB(j)  (1280 + 64 * (j))
#define XB_XGEN(j)  (2304 + 64 * (j))
#define XB_TOP      3328
#define XB_TOPGEN   3392
#define XCD_BAR_WORDS 3456
#define XB_SPIN_CAP (1u << 18)
__device__ __forceinline__ unsigned xb_ld(unsigned* p)              { return __hip_atomic_load(p, __ATOMIC_RELAXED, __HIP_MEMORY_SCOPE_AGENT); }
__device__ __forceinline__ unsigned xb_add(unsigned* p, unsigned v) { return __hip_atomic_fetch_add(p, v, __ATOMIC_RELAXED, __HIP_MEMORY_SCOPE_AGENT); }
__device__ __forceinline__ unsigned xb_xcc_id() { return (unsigned)__builtin_amdgcn_s_getreg((3 << 11) | 20) & 0xFu; }
#define XB_SPIN(cond, bar) do { unsigned _sp = 0; while (cond) { __builtin_amdgcn_s_sleep(1); \
    if ((++_sp & 255u) == 0u) { if (xb_ld(&(bar)[XB_TMO])) break; if (_sp > XB_SPIN_CAP) { atomicAdd(&(bar)[XB_TMO], 1u); break; } } } } while (0)
struct XcdBarrier { unsigned* bar; unsigned x; volatile LAS unsigned* st; };
__device__ __forceinline__ XcdBarrier xcd_barrier_post(unsigned* bar, volatile LAS unsigned* st) {
    XcdBarrier b; b.bar = bar; b.x = xb_xcc_id(); b.st = st;
    if (threadIdx.x == 0) (void)xb_add(&bar[XB_XCNT(b.x)], 1u);
    return b;
}
__device__ __forceinline__ void xcd_barrier_complete(unsigned* bar, unsigned x, unsigned& nloc, unsigned& nx) {
    const unsigned G = gridDim.x * gridDim.y * gridDim.z;
    unsigned sum, cnt, mine, sp = 0u;
    for (;;) {
        sum = 0u; cnt = 0u; mine = 0u;
#pragma unroll
        for (unsigned j = 0; j < 16; ++j) { const unsigned c = xb_ld(&bar[XB_XCNT(j)]); sum += c; cnt += (c > 0u) ? 1u : 0u; mine = (j == x) ? c : mine; }
        if (sum == G) break;
        __builtin_amdgcn_s_sleep(1);
        if ((++sp & 255u) == 0u) { if (xb_ld(&bar[XB_TMO])) break; if (sp > XB_SPIN_CAP) { atomicAdd(&bar[XB_TMO], 1u); break; } }
    }
    nloc = mine > 0u ? mine : 1u; nx = cnt > 0u ? cnt : 1u;
}
__device__ __forceinline__ void xcd_barrier(const XcdBarrier& b) {
    asm volatile("s_waitcnt vmcnt(0)" ::: "memory");
    __syncthreads();
    if (threadIdx.x == 0) {
        unsigned* bar = b.bar;
        __builtin_amdgcn_s_waitcnt(0);
        unsigned nloc = b.st[0], nx = b.st[1];
        if (nloc == 0u) { xcd_barrier_complete(bar, b.x, nloc, nx); b.st[0] = nloc; b.st[1] = nx; }
        const unsigned old = xb_add(&bar[XB_XSUB(b.x)], 1u);
        const unsigned gen = old / nloc;
        if (old + 1u == (gen + 1u) * nloc) {
            __builtin_amdgcn_fence(__ATOMIC_RELEASE, "agent");
            asm volatile("s_waitcnt vmcnt(0)" ::: "memory");
            const unsigned og = xb_add(&bar[XB_TOP], 1u);
            const unsigned tg = og / nx;
            if (og + 1u == (tg + 1u) * nx) xb_add(&bar[XB_TOPGEN], 1u);
            else XB_SPIN(xb_ld(&bar[XB_TOPGEN]) == tg, bar);
            __builtin_amdgcn_fence(__ATOMIC_ACQUIRE, "agent");
            xb_add(&bar[XB_XGEN(b.x)], 1u);
            asm volatile("s_waitcnt vmcnt(0)" ::: "memory");
        } else {
            XB_SPIN(xb_ld(&bar[XB_XGEN(b.x)]) == gen, bar);
            __builtin_amdgcn_fence(__ATOMIC_ACQUIRE, "agent");
            asm volatile("s_waitcnt vmcnt(0)" ::: "memory");
        }
    }
    __syncthreads();
}

#ifndef PANE_EXPR
#define PANE_EXPR __builtin_amdgcn_readfirstlane(pane[u.pm])
#endif
namespace pg8 {
constexpr int BM = 256, BK = 64, HALF = 128, HTB = HALF * BK * 2, STAGE_BYTES = 8 * HTB, NXCD = 8, WGM = 8;
__host__ __device__ __forceinline__ int lds_byte(int r, int c) { const int st = (r >> 4) * 2 + (c >> 5), rr = r & 15, cc = c & 31, ob = rr * 64 + cc * 2; return st * 1024 + (ob ^ (((ob >> 9) & 1) << 5)); }
__host__ __device__ __forceinline__ void stage_rc(int b, int& R, int& C) { const int st = b / 1024, sb = b % 1024, swz = sb ^ (((sb >> 9) & 1) << 5); R = (st >> 1) * 16 + swz / 64; C = (st & 1) * 32 + (swz % 64) / 2; }
__host__ __device__ __forceinline__ int perm32(int rho) { const int n = rho >> 4, i = rho & 15; return 8 * (i >> 2) + 4 * n + (i & 3); }

struct Unit { int pm, pn, pb, sel; };

struct StaticOrder {
    int nM, nN, nwg, G, c;
    __device__ void init(int nM_, int nN_, int G_, int c_) { nM = nM_; nN = nN_; nwg = nM * nN; G = G_; c = c_; }
    __device__ bool next(int i, Unit& u) const {
        const long L = (long)i * G + c; if (L >= nwg) return false;
        int wgid = (int)L; { const int q = nwg / NXCD, r = nwg % NXCD, xcd = wgid % NXCD, off = wgid / NXCD; wgid = (xcd < r ? xcd * (q + 1) : r * (q + 1) + (xcd - r) * q) + off; }
        const int nig = WGM * nN, gid = wgid / nig, fm = gid * WGM, gsz = (nM - fm) < WGM ? (nM - fm) : WGM;
        u.pm = fm + ((wgid % nig) % gsz); u.pn = (wgid % nig) / gsz; u.pb = u.pn; u.sel = 0; return true;
    }
};
struct PairOrder {
    StaticOrder so;
    __device__ bool next(int i, Unit& u) const { if (!so.next(i >> 1, u)) return false; u.sel = i & 1; return true; }
};
struct SubsetOrder {
    int nu, nw, r;
    __device__ bool next(int i, Unit& u) const { const int L = i * nw + r; if (L >= nu) return false; u.pm = L >> 2; u.pn = L & 3; u.pb = u.pn; u.sel = 0; return true; }
};
struct MoeOrder {
    const volatile LAS int* pane; int np, G, c;
    __device__ bool next(int i, Unit& u) const {
        const int L = i * G + c; if (L >= np * 4) return false;
        const int v = __builtin_amdgcn_readfirstlane(pane[L >> 2]); u.pm = v & 0xffff; u.pn = L & 3; u.pb = (v >> 16) * 4 + u.pn; u.sel = 0; return true;
    }
};

template <class Epi, class Sched>
__device__ __forceinline__ void gemm_phase(const int tid, LAS unsigned char* lds, const bf16* Aop, const bf16* Bop, const int K_, const Sched& S, const Epi& E, const bf16* Aop1 = nullptr, const bf16* Bop1 = nullptr) {
    int K = K_; asm volatile("" : "+s"(K));
    const int wid = __builtin_amdgcn_readfirstlane(tid >> 6), lane = tid & 63, wr = wid >> 2, wc = wid & 3, fr = lane & 15, fq = lane >> 4;
    const int nt = K / BK;
    unsigned voffA[2], voffB[2];
#pragma unroll
    for (int i = 0; i < 2; ++i) { int R, C; stage_rc(tid * 16 + i * 8192, R, C); const int Rb = Epi::PERM ? ((R & ~31) + perm32(R & 31)) : R;
        voffA[i] = (unsigned)(R * K + C) * 2u; voffB[i] = (unsigned)(Rb * K + C) * 2u; }
    const size_t kstep = (size_t)(BK * 2);
    const size_t hstep = (size_t)HALF * K * 2;
    const size_t tstep = 2 * hstep;
    const unsigned ldsw = (unsigned)wid * 1024u;
    const int aoff = lds_byte(wr * 64 + fr, fq * 8), boff = lds_byte(wc * 32 + fr, fq * 8);
#define PG8_SA(b, h) (((b) * 2 + (h)) * HTB)
#define PG8_SB(b, h) ((4 + (b) * 2 + (h)) * HTB)
#define PG8_STAGE(bufoff, gbase, voff) do { _Pragma("unroll") for (int _i = 0; _i < 2; ++_i) \
        __builtin_amdgcn_global_load_lds((const unsigned*)((const char*)(gbase) + (voff)[_i]), (LAS unsigned*)(lds + (bufoff) + ldsw + _i * 8192), 16, 0, 0); } while (0)
#define PG8_LDA(dst, b, h) do { _Pragma("unroll") for (int m = 0; m < 4; ++m) _Pragma("unroll") for (int k = 0; k < 2; ++k) dst[m][k] = *(const LAS bf16x8*)(lds + PG8_SA(b, h) + aoff + m * 2048 + k * 1024); } while (0)
#define PG8_LDB(dst, b, h) do { _Pragma("unroll") for (int n = 0; n < 2; ++n) _Pragma("unroll") for (int k = 0; k < 2; ++k) dst[n][k] = *(const LAS bf16x8*)(lds + PG8_SB(b, h) + boff + n * 2048 + k * 1024); } while (0)
#define PG8_MMA(ai, bj, At, Bt) do { __builtin_amdgcn_s_setprio(1); _Pragma("unroll") for (int m = 0; m < 4; ++m) _Pragma("unroll") for (int n = 0; n < 2; ++n) _Pragma("unroll") for (int k = 0; k < 2; ++k) \
        acc[ai][bj][m][n] = __builtin_amdgcn_mfma_f32_16x16x32_bf16(Bt[n][k], At[m][k], acc[ai][bj][m][n], 0, 0, 0); __builtin_amdgcn_s_setprio(0); } while (0)
#define PG8_WAIT_V(n) asm volatile("s_waitcnt vmcnt(" #n ")" ::: "memory")
#define PG8_WAIT_L(n) asm volatile("s_waitcnt lgkmcnt(" #n ")" ::: "memory")
#define PG8_BAR __builtin_amdgcn_s_barrier()
#define PG8_SCHED __builtin_amdgcn_sched_barrier(0)
    Unit cur, nxt; int ui = 0;
    if (!S.next(0, cur)) return;
    f32x4 acc[2][2][4][2];
#pragma unroll
    for (int a = 0; a < 2; ++a)
#pragma unroll
        for (int b = 0; b < 2; ++b)
#pragma unroll
            for (int m = 0; m < 4; ++m)
#pragma unroll
                for (int n = 0; n < 2; ++n) acc[a][b][m][n] = (f32x4){0.f, 0.f, 0.f, 0.f};
    bf16x8 At[4][2], B0[2][2], B1[2][2];
    const char* cA = (const char*)((Aop1 && cur.sel) ? Aop1 : Aop) + (size_t)cur.pm * tstep; const char* cB = (const char*)((Bop1 && cur.sel) ? Bop1 : Bop) + (size_t)cur.pb * tstep;
    PG8_STAGE(PG8_SB(0, 0), cB, voffB); PG8_STAGE(PG8_SB(0, 1), cB + hstep, voffB); PG8_STAGE(PG8_SA(0, 0), cA, voffA); PG8_STAGE(PG8_SA(0, 1), cA + hstep, voffA);
    if (wr == 1) PG8_BAR;
    PG8_WAIT_V(2); PG8_BAR;
    PG8_STAGE(PG8_SB(1, 0), cB + kstep, voffB); PG8_STAGE(PG8_SA(1, 0), cA + kstep, voffA); PG8_STAGE(PG8_SB(1, 1), cB + hstep + kstep, voffB);
    PG8_WAIT_V(6); PG8_BAR;
    for (;;) {
        const bool has_next = S.next(ui + 1, nxt);
        const char* nA = has_next ? (const char*)((Aop1 && nxt.sel) ? Aop1 : Aop) + (size_t)nxt.pm * tstep : cA; const char* nB = has_next ? (const char*)((Bop1 && nxt.sel) ? Bop1 : Bop) + (size_t)nxt.pb * tstep : cB;
        for (int t = 0; t < nt; t += 2) {
            const bool last = (t == nt - 2);
            const char* a1 = cA + (size_t)(t + 1) * kstep;
            const char* a2 = last ? nA : cA + (size_t)(t + 2) * kstep; const char* b2 = last ? nB : cB + (size_t)(t + 2) * kstep;
            const char* a3 = a2 + kstep; const char* b3 = b2 + kstep;
            PG8_LDB(B0, 0, 0); PG8_LDB(B1, 0, 1); PG8_SCHED; PG8_LDA(At, 0, 0); PG8_STAGE(PG8_SA(1, 1), a1 + hstep, voffA);
            PG8_WAIT_V(8); PG8_WAIT_L(0); PG8_BAR; PG8_MMA(0, 0, At, B0); PG8_MMA(0, 1, At, B1); PG8_BAR; PG8_SCHED;
            PG8_LDA(At, 0, 1); PG8_STAGE(PG8_SB(0, 0), b2, voffB); PG8_STAGE(PG8_SB(0, 1), b2 + hstep, voffB); PG8_STAGE(PG8_SA(0, 0), a2, voffA);
            PG8_WAIT_V(8); PG8_WAIT_L(0); PG8_BAR; PG8_MMA(1, 0, At, B0); PG8_MMA(1, 1, At, B1); PG8_BAR; PG8_SCHED;
            PG8_LDB(B0, 1, 0); PG8_LDB(B1, 1, 1); PG8_SCHED; PG8_LDA(At, 1, 0); PG8_STAGE(PG8_SA(0, 1), a2 + hstep, voffA);
            PG8_WAIT_V(8); PG8_WAIT_L(0); PG8_BAR; PG8_MMA(0, 0, At, B0); PG8_MMA(0, 1, At, B1); PG8_BAR; PG8_SCHED;
            PG8_LDA(At, 1, 1); PG8_STAGE(PG8_SB(1, 0), b3, voffB); PG8_STAGE(PG8_SB(1, 1), b3 + hstep, voffB); PG8_STAGE(PG8_SA(1, 0), a3, voffA);
            PG8_WAIT_V(8); PG8_WAIT_L(0); PG8_BAR; PG8_MMA(1, 0, At, B0); PG8_MMA(1, 1, At, B1); PG8_BAR; PG8_SCHED;
        }
        if (wr == 0) PG8_BAR;
        E(acc, cur, wr, wc, fr, fq);
        if (!has_next) break;
#pragma unroll
        for (int a = 0; a < 2; ++a)
#pragma unroll
            for (int b = 0; b < 2; ++b)
#pragma unroll
                for (int m = 0; m < 4; ++m)
#pragma unroll
                    for (int n = 0; n < 2; ++n) acc[a][b][m][n] = (f32x4){0.f, 0.f, 0.f, 0.f};
        cur = nxt; cA = nA; cB = nB; ++ui;
        if (wr == 1) PG8_BAR;
    }
    PG8_WAIT_V(0);
    PG8_BAR;
#undef PG8_SA
#undef PG8_SB
#undef PG8_STAGE
#undef PG8_LDA
#undef PG8_LDB
#undef PG8_MMA
#undef PG8_WAIT_V
#undef PG8_WAIT_L
#undef PG8_BAR
#undef PG8_SCHED
}
}

using pg8::Unit;
struct EpiIn {
    static constexpr bool PERM = true;
    unsigned char* ws; float* out; const float* bias; int L;
    __device__ __forceinline__ void operator()(const f32x4 (&acc)[2][2][4][2], const Unit& u, int wr, int wc, int fr, int fq) const {
        const int pn = u.pn; size_t boff; int ld, ct; float sc = 1.f; int act = 0, st = 0;
        if (pn < 2) { boff = WS_QM; ld = 512; ct = pn * 256; sc = 0.08838834764831845f; }
        else if (pn < 4) { boff = WS_KM; ld = 512; ct = (pn - 2) * 256; }
        else if (pn < 8) { boff = WS_VM; ld = 1024; ct = (pn - 4) * 256; }
        else if (pn < 12) { boff = WS_OG; ld = 1024; ct = (pn - 8) * 256; act = 1; }
        else if (pn < 16) { boff = WS_QS; ld = 1024; ct = (pn - 12) * 256; sc = 0.125f; }
        else if (pn == 16) { boff = WS_KS; ld = 256; ct = 0; st = 1; }
        else if (pn == 17) { boff = WS_VS; ld = 256; ct = 0; st = 2; }
        else if (pn < 22) { boff = WS_GA; ld = 1024; ct = (pn - 18) * 256; act = 1; }
        else { boff = WS_GB; ld = 1024; ct = (pn - 22) * 256; act = 1; }
        bf16* base = (bf16*)(ws + boff);
        float* so_p = out + (st == 1 ? O_KP : O_VP) + (size_t)L * 8 * 32768; float* so_s = out + (st == 1 ? O_KS : O_VS) + (size_t)L * 128 * 32768;
        const int cl = wc * 32 + 8 * fq;
        const int bcol0 = pn * 256 + cl + (pn < 12 ? 0 : 8);
        f32x4 bv[2][2];
#pragma unroll
        for (int bj = 0; bj < 2; ++bj)
#pragma unroll
            for (int n = 0; n < 2; ++n) bv[bj][n] = *(const f32x4*)(bias + bcol0 + bj * 128 + 4 * n);
#pragma unroll
        for (int ai = 0; ai < 2; ++ai)
#pragma unroll
            for (int m = 0; m < 4; ++m) {
                const int rloc = ai * 128 + wr * 64 + m * 16 + fr; const size_t row = (size_t)u.pm * 256 + rloc;
                bf16* rowp = base + row * ld + ct + cl;
                float* sp = nullptr;
                if (st) {
                    if (u.pm >= 64) { const int rs = (u.pm - 64) * 256 + rloc; sp = so_s + ((size_t)(rs >> 2) * 128 + 124 + (rs & 3)) * 256 + cl; }
                    else if ((u.pm & 7) == 7 && ai == 1) { sp = so_p + ((size_t)(u.pm >> 3) * 128 + (rloc - 128)) * 256 + cl; }
                }
#pragma unroll
                for (int bj = 0; bj < 2; ++bj) {
                    f32x4 v0 = (acc[ai][bj][m][0] + bv[bj][0]) * sc, v1 = (acc[ai][bj][m][1] + bv[bj][1]) * sc;
                    if (act) {
#pragma unroll
                        for (int j = 0; j < 4; ++j) { v0[j] = sigmoid_fast(v0[j]); v1[j] = sigmoid_fast(v1[j]); }
                    }
                    u32x4 w; w.x = pk2(v0[0], v0[1]); w.y = pk2(v0[2], v0[3]); w.z = pk2(v1[0], v1[1]); w.w = pk2(v1[2], v1[3]);
                    if (act) __builtin_nontemporal_store(w, (u32x4*)(rowp + bj * 128)); else *(u32x4*)(rowp + bj * 128) = w;
                    if (sp) { *(f32x4*)(sp + bj * 128) = v0; *(f32x4*)(sp + bj * 128 + 4) = v1; }
                }
            }
    }
};
template <int MODE> struct EpiF {
    static constexpr bool PERM = true;
    bf16* X; float* T1; const bf16* G; bf16* U; bf16* Xo;
    struct Pre { u32x2 g, x; f32x4 t; };
    __device__ __forceinline__ Pre pre(const size_t o) const { Pre p; p.g = (u32x2){0u, 0u}; p.x = (u32x2){0u, 0u}; p.t = (f32x4){0.f, 0.f, 0.f, 0.f};
        if (MODE == 0) p.g = *(const u32x2*)(G + o);
        if (MODE == 1) { p.g = *(const u32x2*)(G + o); p.x = *(const u32x2*)((const bf16*)T1 + o); }
        if (MODE == 2) p.x = *(const u32x2*)(X + o);
        if (MODE == 4) { p.x = *(const u32x2*)(X + o); const u32x2 tb = *(const u32x2*)((const bf16*)T1 + o); p.t = (f32x4){bflo(tb.x), bfhi(tb.x), bflo(tb.y), bfhi(tb.y)}; }
        return p; }
    __device__ __forceinline__ void fin(const size_t o, const f32x4 a, const Pre& p) const {
        if (MODE == 0) { u32x2 w; w.x = pk2(bflo(p.g.x) * a[0], bfhi(p.g.x) * a[1]); w.y = pk2(bflo(p.g.y) * a[2], bfhi(p.g.y) * a[3]); *(u32x2*)((bf16*)T1 + o) = w; }
        if (MODE == 1) { u32x2 w; w.x = pk2(bflo(p.x.x) + bflo(p.g.x) * a[0], bfhi(p.x.x) + bfhi(p.g.x) * a[1]); w.y = pk2(bflo(p.x.y) + bflo(p.g.y) * a[2], bfhi(p.x.y) + bfhi(p.g.y) * a[3]); *(u32x2*)(U + o) = w; }
        if (MODE == 2) { u32x2 w; w.x = pk2(bflo(p.x.x) * DN_ALPHA + a[0], bfhi(p.x.x) * DN_ALPHA + a[1]); w.y = pk2(bflo(p.x.y) * DN_ALPHA + a[2], bfhi(p.x.y) * DN_ALPHA + a[3]); *(u32x2*)(X + o) = w; }
        if (MODE == 3) { u32x2 w; w.x = pk2(a[0], a[1]); w.y = pk2(a[2], a[3]); *(u32x2*)((bf16*)T1 + o) = w; }
        if (MODE == 4) { u32x2 w; w.x = pk2(bflo(p.x.x) * DN_ALPHA + sigmoid_fast(a[0]) * p.t[0], bfhi(p.x.x) * DN_ALPHA + sigmoid_fast(a[1]) * p.t[1]); w.y = pk2(bflo(p.x.y) * DN_ALPHA + sigmoid_fast(a[2]) * p.t[2], bfhi(p.x.y) * DN_ALPHA + sigmoid_fast(a[3]) * p.t[3]);
            *(u32x2*)(Xo + o) = w; }
    }
    __device__ __forceinline__ void elem(const size_t o, const f32x4 a) const { fin(o, a, pre(o)); }
    __device__ __forceinline__ void op8(const size_t o, const f32x4 a0, const f32x4 a1) const {
        const float a[8] = {a0[0], a0[1], a0[2], a0[3], a1[0], a1[1], a1[2], a1[3]};
        u32x4 g = (u32x4){0u, 0u, 0u, 0u}, x = (u32x4){0u, 0u, 0u, 0u}, t = (u32x4){0u, 0u, 0u, 0u};
        if (MODE == 0 || MODE == 1) g = *(const u32x4*)(G + o);
        if (MODE == 1 || MODE == 4) t = *(const u32x4*)((const bf16*)T1 + o);
        if (MODE == 2 || MODE == 4) x = *(const u32x4*)(X + o);
        const unsigned gw[4] = {g.x, g.y, g.z, g.w}, xw[4] = {x.x, x.y, x.z, x.w}, tw[4] = {t.x, t.y, t.z, t.w};
        unsigned w[4];
#pragma unroll
        for (int q = 0; q < 4; ++q) { float lo = 0.f, hi = 0.f;
            if (MODE == 0) { lo = bflo(gw[q]) * a[2 * q]; hi = bfhi(gw[q]) * a[2 * q + 1]; }
            if (MODE == 1) { lo = bflo(tw[q]) + bflo(gw[q]) * a[2 * q]; hi = bfhi(tw[q]) + bfhi(gw[q]) * a[2 * q + 1]; }
            if (MODE == 2) { lo = bflo(xw[q]) * DN_ALPHA + a[2 * q]; hi = bfhi(xw[q]) * DN_ALPHA + a[2 * q + 1]; }
            if (MODE == 3) { lo = a[2 * q]; hi = a[2 * q + 1]; }
            if (MODE == 4) { lo = bflo(xw[q]) * DN_ALPHA + sigmoid_fast(a[2 * q]) * bflo(tw[q]); hi = bfhi(xw[q]) * DN_ALPHA + sigmoid_fast(a[2 * q + 1]) * bfhi(tw[q]); }
            w[q] = pk2(lo, hi); }
        const u32x4 ov = (u32x4){w[0], w[1], w[2], w[3]};
        if (MODE == 0 || MODE == 3) *(u32x4*)((bf16*)T1 + o) = ov;
        if (MODE == 1) *(u32x4*)(U + o) = ov;
        if (MODE == 2) *(u32x4*)(X + o) = ov;
        if (MODE == 4) *(u32x4*)(Xo + o) = ov;
    }
    __device__ __forceinline__ void operator()(const f32x4 (&acc)[2][2][4][2], const Unit& u, int wr, int wc, int fr, int fq) const {
        const int col0 = u.pn * 256 + wc * 32 + 8 * fq;
#pragma unroll
        for (int ai = 0; ai < 2; ++ai)
#pragma unroll
            for (int m = 0; m < 4; ++m) {
                const size_t off = ((size_t)u.pm * 256 + ai * 128 + wr * 64 + m * 16 + fr) * 1024 + col0;
#pragma unroll
                for (int bj = 0; bj < 2; ++bj) op8(off + bj * 128, acc[ai][bj][m][0], acc[ai][bj][m][1]);
                asm volatile("" ::: "memory");
            }
    }
};
struct EpiAB {
    static constexpr bool PERM = true;
    EpiF<0> e0; EpiF<1> e1;
    __device__ __forceinline__ void operator()(const f32x4 (&acc)[2][2][4][2], const Unit& u, int wr, int wc, int fr, int fq) const { if (u.sel == 0) e0(acc, u, wr, wc, fr, fq); else e1(acc, u, wr, wc, fr, fq); }
};
struct EpiGU {
    static constexpr bool PERM = true;
    bf16* H;
    __device__ __forceinline__ void operator()(const f32x4 (&acc)[2][2][4][2], const Unit& u, int wr, int wc, int fr, int fq) const {
        const int col0 = u.pn * 128 + wc * 32 + 8 * fq;
#pragma unroll
        for (int ai = 0; ai < 2; ++ai)
#pragma unroll
            for (int m = 0; m < 4; ++m) {
                bf16* rowp = H + ((size_t)u.pm * 256 + ai * 128 + wr * 64 + m * 16 + fr) * 512 + col0;
                float h[8];
#pragma unroll
                for (int n = 0; n < 2; ++n)
#pragma unroll
                    for (int j = 0; j < 4; ++j) { const float g = acc[ai][0][m][n][j], up = acc[ai][1][m][n][j]; h[n * 4 + j] = g * sigmoid_fast(g) * up; }
                u32x4 w; w.x = pk2(h[0], h[1]); w.y = pk2(h[2], h[3]); w.z = pk2(h[4], h[5]); w.w = pk2(h[6], h[7]);
                *(u32x4*)rowp = w;
            }
    }
};
struct EpiDN {
    static constexpr bool PERM = true;
    bf16* Y;
    __device__ __forceinline__ void operator()(const f32x4 (&acc)[2][2][4][2], const Unit& u, int wr, int wc, int fr, int fq) const {
        const int col0 = u.pn * 256 + wc * 32 + 8 * fq;
#pragma unroll
        for (int ai = 0; ai < 2; ++ai)
#pragma unroll
            for (int m = 0; m < 4; ++m) {
                bf16* rowp = Y + ((size_t)u.pm * 256 + ai * 128 + wr * 64 + m * 16 + fr) * 1024 + col0;
#pragma unroll
                for (int bj = 0; bj < 2; ++bj) { const f32x4 v0 = acc[ai][bj][m][0], v1 = acc[ai][bj][m][1];
                    u32x4 w; w.x = pk2(v0[0], v0[1]); w.y = pk2(v0[2], v0[3]); w.z = pk2(v1[0], v1[1]); w.w = pk2(v1[2], v1[3]);
                    *(u32x4*)(rowp + bj * 128) = w; }
            }
    }
};

struct Args { const float* in[28]; float* out; unsigned char* ws; int ph_lo, ph_hi; };
typedef __attribute__((address_space(4))) const Args CArgs;
struct Frame {
    LAS unsigned char* lds; volatile LAS unsigned* LW; unsigned* ctl;
    int tid, lane, wave, G, gw, NGW, bid;
    float* out; unsigned char* ws;
};
#define WSP(T_, off) ((T_*)(F.ws + (off)))
#define REFRESH_LANE(F_) do { unsigned z_ = 0u; asm volatile("" : "+s"(z_)); (F_).lane = (int)__builtin_amdgcn_mbcnt_hi(~0u, __builtin_amdgcn_mbcnt_lo(~0u, z_)); (F_).tid = (F_).wave * 64 + (F_).lane; } while (0)
#define WSW(T_, off, L_) ((T_*)(F.ws + (off) + (size_t)((L_) & 1) * WSET_SHIFT))

template <class Epi>
__device__ __forceinline__ void small_gemm(const Frame& F, const bf16* Aop, const bf16* Bop, const int K_, const Epi& E) {
    int K = K_; asm volatile("" : "+s"(K));
    for (int piece = F.bid; piece < 256; piece += F.G) {
    const int rt = piece & 7, ct = piece >> 3, fr = F.lane & 15, fq = F.lane >> 4;
    const int kw = K >> 3, k0 = F.wave * kw;
    const bf16* Ab = Aop + (size_t)(TP + 64 * rt + fr) * K + k0 + 8 * fq; const bf16* Bb = Bop + (size_t)(32 * ct + fr) * K + k0 + 8 * fq;
    const size_t eo = (size_t)(TP + 64 * rt + (F.tid >> 3)) * 1024 + 32 * ct + (F.tid & 7) * 4; const typename Epi::Pre ep = E.pre(eo);
    f32x4 acc[4][2];
#pragma unroll
    for (int mt = 0; mt < 4; ++mt)
#pragma unroll
        for (int nt = 0; nt < 2; ++nt) acc[mt][nt] = (f32x4){0.f, 0.f, 0.f, 0.f};
    if (kw == 128) {
        bf16x8 af[4][4], bf[2][4];
#pragma unroll
        for (int ks = 0; ks < 4; ++ks) {
#pragma unroll
            for (int mt = 0; mt < 4; ++mt) af[mt][ks] = *(const bf16x8*)(Ab + (size_t)(16 * mt) * K + 32 * ks);
#pragma unroll
            for (int nt = 0; nt < 2; ++nt) bf[nt][ks] = *(const bf16x8*)(Bb + (size_t)(16 * nt) * K + 32 * ks); }
#pragma unroll
        for (int ks = 0; ks < 4; ++ks)
#pragma unroll
            for (int mt = 0; mt < 4; ++mt)
#pragma unroll
                for (int nt = 0; nt < 2; ++nt) acc[mt][nt] = __builtin_amdgcn_mfma_f32_16x16x32_bf16(bf[nt][ks], af[mt][ks], acc[mt][nt], 0, 0, 0);
    } else {
        bf16x8 af[4], bf[2];
#pragma unroll
        for (int mt = 0; mt < 4; ++mt) af[mt] = *(const bf16x8*)(Ab + (size_t)(16 * mt) * K);
#pragma unroll
        for (int nt = 0; nt < 2; ++nt) bf[nt] = *(const bf16x8*)(Bb + (size_t)(16 * nt) * K);
#pragma unroll
        for (int mt = 0; mt < 4; ++mt)
#pragma unroll
            for (int nt = 0; nt < 2; ++nt) acc[mt][nt] = __builtin_amdgcn_mfma_f32_16x16x32_bf16(bf[nt], af[mt], acc[mt][nt], 0, 0, 0);
    }
    LAS float* red = (LAS float*)F.lds;
#pragma unroll
    for (int mt = 0; mt < 4; ++mt)
#pragma unroll
        for (int nt = 0; nt < 2; ++nt) *(LAS f32x4*)(red + (F.wave * 64 + 16 * mt + fr) * 32 + 16 * nt + 4 * fq) = acc[mt][nt];
    __syncthreads();
    { const int row = F.tid >> 3, c4 = (F.tid & 7) * 4; f32x4 s = *(const LAS f32x4*)(red + row * 32 + c4);
#pragma unroll
      for (int w = 1; w < 8; ++w) s += *(const LAS f32x4*)(red + (w * 64 + row) * 32 + c4);
      E.fin(eo, s, ep); }
    __syncthreads();
    }
}

template <bool NTST = false> __device__ __forceinline__ void tr_item(const float* W, int ldw, int K, bf16* WT, int kb, int nsrc0, int ndst0, LAS float* scr, int lane) {
    const int k0 = 64 * kb, r = lane >> 3, c4 = lane & 7;
    f32x4 x[8];
#pragma unroll
    for (int i = 0; i < 8; ++i) x[i] = __builtin_nontemporal_load((const f32x4*)(W + (size_t)(k0 + 8 * i + r) * ldw + nsrc0 + 4 * c4));
#pragma unroll
    for (int i = 0; i < 8; ++i) { LAS float* d = scr + (8 * i + r) * 33 + 4 * c4; d[0] = x[i][0]; d[1] = x[i][1]; d[2] = x[i][2]; d[3] = x[i][3]; }
    LDS_WAIT(); asm volatile("" ::: "memory");
    const int c = lane & 7;
#pragma unroll
    for (int j = 0; j < 4; ++j) { const int n = (lane >> 3) + 8 * j; const LAS float* s = scr + (8 * c) * 33 + n;
        u32x4 o; o.x = pk2(s[0 * 33], s[1 * 33]); o.y = pk2(s[2 * 33], s[3 * 33]); o.z = pk2(s[4 * 33], s[5 * 33]); o.w = pk2(s[6 * 33], s[7 * 33]);
        if (NTST) __builtin_nontemporal_store(o, (u32x4*)(WT + (size_t)(ndst0 + n) * K + k0 + 8 * c)); else *(u32x4*)(WT + (size_t)(ndst0 + n) * K + k0 + 8 * c) = o; }
    LDS_WAIT(); asm volatile("" ::: "memory");
}
constexpr int CV_I1 = 16 * 96, CV_I2 = 16 * 112, CV_I3 = 512, CV_IPP = 128, CV_IE = 8192, CV_N = CV_I1 + CV_I2 + 4 * CV_I3 + CV_IPP + 3 * CV_IE;
__device__ __forceinline__ void conv_item(CArgs& A, Frame& F, int L, int it) {
    LAS float* scr = (LAS float*)(F.lds + F.wave * 8704);
    int r = it;
    if (r < 2 * CV_IE) { const int up = r >= CV_IE; if (up) r -= CV_IE; const int e = r >> 8, q = r & 255, kb = q >> 4, nb = q & 15;
        tr_item<true>(A.in[up ? 24 : 23] + ((size_t)L * NEXP + e) * D * DEXP, DEXP, D, WSW(bf16, WS_WGU, L) + (size_t)e * D * D, kb, 32 * nb, 256 * (nb >> 2) + (up ? 128 : 0) + 32 * (nb & 3), scr, F.lane); return; } r -= 2 * CV_IE;
    if (r < CV_IE) { const int e = r >> 8, q = r & 255, kb = q >> 5, nb = q & 31;
        tr_item<true>(A.in[25] + ((size_t)L * NEXP + e) * DEXP * D, D, DEXP, WSW(bf16, WS_WD, L) + (size_t)e * D * DEXP, kb, 32 * nb, 32 * nb, scr, F.lane); return; } r -= CV_IE;
    const float* w_in = A.in[9] + (size_t)L * D * DIN;
    if (r < CV_I1) { tr_item(w_in, DIN, D, WSW(bf16, WS_WIN, L), r / 96, 32 * (r % 96), 32 * (r % 96), scr, F.lane); return; } r -= CV_I1;
    if (r < CV_I2) { tr_item(w_in, DIN, D, WSW(bf16, WS_WIN, L), r / 112, 3080 + 32 * (r % 112), 3072 + 32 * (r % 112), scr, F.lane); return; } r -= CV_I2;
    if (r < 4 * CV_I3) { const int which = r >> 9, q = r & 511; const float* srcw = A.in[which == 0 ? 12 : which == 1 ? 13 : which == 2 ? 14 : 26] + (size_t)L * D * D;
        tr_item(srcw, D, D, WSW(bf16, WS_WA, L) + (size_t)which * D * D, q / 32, 32 * (q % 32), 32 * (q % 32), scr, F.lane); return; } r -= 4 * CV_I3;
    tr_item(A.in[27] + (size_t)L * DPLE * D, D, DPLE, WSW(bf16, WS_WPP, L), r / 32, 32 * (r % 32), 32 * (r % 32), scr, F.lane);
}
__device__ __forceinline__ void convert_range(CArgs& A, Frame& F, int L, int lo, int hi, int nw, int r) {
    for (int it = lo + r * NW + F.wave; it < hi; it += nw * NW) conv_item(A, F, L, it);
}
constexpr int CV_G = 14000, CV_D = CV_G + 3200, CV_I = CV_D + 6400;
__device__ __forceinline__ void convert_layer(CArgs& A, Frame& F, int L, int lo) {
    convert_range(A, F, L, lo, CV_N, F.G, F.bid);
    { const float* w_rg = A.in[19] + (size_t)L * D * 4; const float* w_re = A.in[21] + (size_t)L * D * 32; bf16* Wh = WSP(bf16, WS_RW); bf16* Wl = Wh + 36 * 1032;
      for (int k = F.bid * NT + F.tid; k < D; k += F.G * NT) {
          float wv[36]; { const f32x4 g4 = *(const f32x4*)(w_rg + k * 4); wv[0] = g4[0]; wv[1] = g4[1]; wv[2] = g4[2]; wv[3] = g4[3]; }
#pragma unroll
          for (int c4 = 0; c4 < 8; ++c4) { const f32x4 e4 = *(const f32x4*)(w_re + k * 32 + 4 * c4); wv[4 + 4 * c4] = e4[0]; wv[5 + 4 * c4] = e4[1]; wv[6 + 4 * c4] = e4[2]; wv[7 + 4 * c4] = e4[3]; }
#pragma unroll
          for (int o = 0; o < 36; ++o) { const unsigned hi = f2bf(wv[o]); Wh[o * 1032 + k] = (bf16)hi; Wl[o * 1032 + k] = (bf16)f2bf(wv[o] - bf2f(hi)); } } }
    const float* pp = A.in[7] + (size_t)L * TP * DPLE; const float* ps = A.in[8] + (size_t)L * TS * DPLE; bf16* pb = WSP(bf16, WS_PB);
    for (size_t i = (size_t)F.bid * NT + F.tid; i < (size_t)T * DPLE / 8; i += (size_t)F.G * NT) {
        const size_t e0 = i * 8; const float* src = e0 < (size_t)TP * DPLE ? pp + e0 : ps + (e0 - (size_t)TP * DPLE);
        const f32x4 a = __builtin_nontemporal_load((const f32x4*)src), b = __builtin_nontemporal_load((const f32x4*)(src + 4));
        u32x4 w; w.x = pk2(a[0], a[1]); w.y = pk2(a[2], a[3]); w.z = pk2(b[0], b[1]); w.w = pk2(b[2], b[3]);
        *(u32x4*)(pb + e0) = w;
    }
}
constexpr int WIG_OFF = 73728;
__device__ __forceinline__ void stage_wig(CArgs& A, Frame& F, int L) {
    const float* w_in = A.in[9] + (size_t)L * D * DIN; LAS float* wig = (LAS float*)(F.lds + WIG_OFF);
    float t[16];
#pragma unroll
    for (int q = 0; q < 16; ++q) { const int i = F.tid + NT * q; t[q] = w_in[(size_t)(i >> 3) * DIN + 3072 + (i & 7)]; }
#pragma unroll
    for (int q = 0; q < 16; ++q) { const int i = F.tid + NT * q; wig[(i & 7) * 1024 + (i >> 3)] = t[q]; }
}
__device__ __forceinline__ void row_range(const Frame& F, int& m0, int& m1) { const int q = T / F.NGW, r = T % F.NGW; m0 = F.gw * q + (F.gw < r ? F.gw : r); m1 = m0 + q + (F.gw < r ? 1 : 0); }
#define RCOL(lane_, q_) (8 * (lane_) + 512 * ((q_) >> 1) + 4 * ((q_) & 1))
__device__ __forceinline__ void row_load(const float* p, int lane, f32x4 (&v)[4]) {
#pragma unroll
    for (int j = 0; j < 4; ++j) v[j] = *(const f32x4*)(p + RCOL(lane, j));
}
__device__ __forceinline__ void row_load_bf(const bf16* p, int lane, f32x4 (&v)[4]) {
#pragma unroll
    for (int j = 0; j < 2; ++j) { const u32x4 w = *(const u32x4*)(p + 8 * lane + 512 * j); v[2 * j] = (f32x4){bflo(w.x), bfhi(w.x), bflo(w.y), bfhi(w.y)}; v[2 * j + 1] = (f32x4){bflo(w.z), bfhi(w.z), bflo(w.w), bfhi(w.w)}; }
}
__device__ __forceinline__ void row_store_bf(bf16* p, int lane, const f32x4 (&v)[4]) {
#pragma unroll
    for (int j = 0; j < 2; ++j) { u32x4 w; w.x = pk2(v[2 * j][0], v[2 * j][1]); w.y = pk2(v[2 * j][2], v[2 * j][3]); w.z = pk2(v[2 * j + 1][0], v[2 * j + 1][1]); w.w = pk2(v[2 * j + 1][2], v[2 * j + 1][3]); *(u32x4*)(p + 8 * lane + 512 * j) = w; }
}
__device__ __forceinline__ void row_raw(const bf16* p, int lane, u32x4 (&r)[2]) { r[0] = *(const u32x4*)(p + 8 * lane); r[1] = *(const u32x4*)(p + 8 * lane + 512); }
__device__ __forceinline__ void row_unpack(const u32x4 (&r)[2], f32x4 (&v)[4]) {
#pragma unroll
    for (int j = 0; j < 2; ++j) { v[2 * j] = (f32x4){bflo(r[j].x), bfhi(r[j].x), bflo(r[j].y), bfhi(r[j].y)}; v[2 * j + 1] = (f32x4){bflo(r[j].z), bfhi(r[j].z), bflo(r[j].w), bfhi(r[j].w)}; }
}
__device__ __forceinline__ void row_ln(f32x4 (&v)[4], const float* g, const float* b, int lane) {
    float s = 0.f;
#pragma unroll
    for (int j = 0; j < 4; ++j) s += (v[j][0] + v[j][1]) + (v[j][2] + v[j][3]);
    const float mean = wave_sum(s) * (1.f / D); float s2 = 0.f;
#pragma unroll
    for (int j = 0; j < 4; ++j) { v[j] = v[j] - mean; s2 += (v[j][0] * v[j][0] + v[j][1] * v[j][1]) + (v[j][2] * v[j][2] + v[j][3] * v[j][3]); }
    const float rstd = 1.0f / sqrtf(wave_sum(s2) * (1.f / D) + LN_EPS);
#pragma unroll
    for (int j = 0; j < 4; ++j) { const f32x4 gg = *(const f32x4*)(g + RCOL(lane, j)), bb = *(const f32x4*)(b + RCOL(lane, j)); v[j] = v[j] * rstd * gg + bb; }
}
__device__ __forceinline__ void row_finalize(CArgs& A, Frame& F, int m, const f32x4 (&v)[4], int Ln) {
    row_store_bf(WSP(bf16, WS_X) + (size_t)m * D, F.lane, v);
    const LAS float* wig = (const LAS float*)(F.lds + WIG_OFF); const float* b_in = A.in[10] + (size_t)Ln * DIN + 3072;
    float r[8];
#pragma unroll
    for (int c = 0; c < 8; ++c) { float s = 0.f;
#pragma unroll
        for (int j = 0; j < 4; ++j) { const f32x4 w = *(const LAS f32x4*)(wig + c * 1024 + RCOL(F.lane, j)); s += (v[j][0] * w[0] + v[j][1] * w[1]) + (v[j][2] * w[2] + v[j][3] * w[3]); }
        r[c] = wave_sum(s); if (c & 1) asm volatile("" ::: "memory"); }
    if (F.lane < 8) { float x = r[0];
#pragma unroll
        for (int c = 1; c < 8; ++c) x = (F.lane == c) ? r[c] : x;
        WSP(float, WS_IGFG)[(size_t)m * 8 + F.lane] = x + b_in[F.lane]; }
}

constexpr int SQ_KS = 136, SQ_VS = 40;
constexpr int SQ_KW = 0, SQ_VT = 2 * 64 * SQ_KS * 2, SQ_G = SQ_VT + 2 * 64 * SQ_VS * 2, SQ_SC = SQ_G + 32 * 64 * 4;
__device__ __forceinline__ void mseq_item(Frame& F, int L, int item) {
    const int bh = item >> 3, vs = item & 7, b = bh >> 2, h = bh & 3;
    LAS float* sg = (LAS float*)(F.lds + SQ_G); LAS float* sbend = (LAS float*)(F.lds + SQ_SC); LAS float* sgmax = sbend + 32; LAS float* sdec = sbend + 64; LAS float* smn = sbend + 96;
    const float* igfg = WSP(float, WS_IGFG);
    { float igv[4], fgv[4];
#pragma unroll
      for (int i = 0; i < 4; ++i) { const int m = b * SEQ + (4 * F.wave + i) * 64 + F.lane; igv[i] = igfg[(size_t)m * 8 + h]; fgv[i] = igfg[(size_t)m * 8 + 4 + h]; }
#pragma unroll
      for (int i = 0; i < 4; ++i) { const int c = 4 * F.wave + i;
        float bc = log_sigmoid(fgv[i]);
#pragma unroll
        for (int o = 1; o < 64; o <<= 1) { const float t = bperm(bc, F.lane - o); if (F.lane >= o) bc += t; }
        const float bend = rdlane(bc, 63); const float g = igv[i] + bend - bc; const float gm = wave_max(g);
        sg[c * 64 + F.lane] = g; if (F.lane == 0) { sbend[c] = bend; sgmax[c] = gm; } } }
    __syncthreads();
    if (F.wave == 0) { const int c = F.lane & 31; const float bend = sbend[c], gmx = sgmax[c]; float a = bend, bq = gmx;
#pragma unroll
        for (int o = 1; o < 32; o <<= 1) { const float ta = bperm(a, F.lane - o), tb = bperm(bq, F.lane - o); if ((F.lane & 31) >= o) { bq = fmaxf(tb + a, bq); a = ta + a; } }
        const float mn = fmaxf(a, bq);
        float mp = bperm(mn, F.lane - 1); if ((F.lane & 31) == 0) mp = 0.f;
        if (F.lane < 32) { sdec[c] = expf(bend + mp - mn); smn[c] = mn; if (vs == 0) { WSP(float, WS_MC)[bh * 32 + c] = mp; if (c == 31) F.out[O_MP + (size_t)L * 32 + bh] = mn; } } }
    __syncthreads();
    for (int i = F.tid; i < 2048; i += NT) sg[i] = expf(sg[i] - smn[i >> 6]);
    __syncthreads();
    const bf16* Km = WSP(bf16, WS_KM); const bf16* Vm = WSP(bf16, WS_VM);
    const int fr = F.lane & 15, fq = F.lane >> 4, tr_r = (F.lane & 15) >> 2, tr_c = F.lane & 3;
    const int ktok = F.tid >> 4, kd8 = F.tid & 15, vtok = (F.tid >> 2) & 63, vv8 = F.tid & 3;
    const bf16* kp = Km + (size_t)(b * SEQ + ktok) * 512 + h * 128 + kd8 * 8; const bf16* vp = Vm + (size_t)(b * SEQ + vtok) * 1024 + h * 256 + 32 * vs + vv8 * 8;
    const size_t kcs = (size_t)64 * 512, vcs = (size_t)64 * 1024;
    u32x4 rkA0 = *(const u32x4*)kp, rkA1 = *(const u32x4*)(kp + 32 * 512), rvA = *(const u32x4*)vp;
    u32x4 rkB0 = *(const u32x4*)(kp + kcs), rkB1 = *(const u32x4*)(kp + kcs + 32 * 512), rvB = *(const u32x4*)(vp + vcs);
    u32x4 rkC0 = *(const u32x4*)(kp + 2 * kcs), rkC1 = *(const u32x4*)(kp + 2 * kcs + 32 * 512), rvC = *(const u32x4*)(vp + 2 * vcs);
    u32x4 rkD0 = *(const u32x4*)(kp + 3 * kcs), rkD1 = *(const u32x4*)(kp + 3 * kcs + 32 * 512), rvD = *(const u32x4*)(vp + 3 * vcs);
    f32x4 acc[2] = {(f32x4){0.f, 0.f, 0.f, 0.f}, (f32x4){0.f, 0.f, 0.f, 0.f}}, nacc = (f32x4){0.f, 0.f, 0.f, 0.f};
    const u32x4 onesw = (u32x4){0x3f803f80u, 0x3f803f80u, 0x3f803f80u, 0x3f803f80u}; const bf16x8 ones = __builtin_bit_cast(bf16x8, onesw);
    bf16* Cc = WSP(bf16, WS_CC); float* NCp = WSP(float, WS_NC);
    const unsigned ldsb = lds_addr(F.lds);
#define MSEQ_STEP(c, rk0, rk1, rv) { \
        LAS bf16* kw = (LAS bf16*)(F.lds + SQ_KW + ((c) & 1) * (64 * SQ_KS * 2)); LAS bf16* vl = (LAS bf16*)(F.lds + SQ_VT + ((c) & 1) * (64 * SQ_VS * 2)); \
        { const float s0 = sg[(c) * 64 + ktok], s1 = sg[(c) * 64 + ktok + 32]; u32x4 w0, w1; \
          w0.x = pk2(bflo(rk0.x) * s0, bfhi(rk0.x) * s0); w0.y = pk2(bflo(rk0.y) * s0, bfhi(rk0.y) * s0); w0.z = pk2(bflo(rk0.z) * s0, bfhi(rk0.z) * s0); w0.w = pk2(bflo(rk0.w) * s0, bfhi(rk0.w) * s0); \
          w1.x = pk2(bflo(rk1.x) * s1, bfhi(rk1.x) * s1); w1.y = pk2(bflo(rk1.y) * s1, bfhi(rk1.y) * s1); w1.z = pk2(bflo(rk1.z) * s1, bfhi(rk1.z) * s1); w1.w = pk2(bflo(rk1.w) * s1, bfhi(rk1.w) * s1); \
          *(LAS u32x4*)(kw + ktok * SQ_KS + kd8 * 8) = w0; *(LAS u32x4*)(kw + (ktok + 32) * SQ_KS + kd8 * 8) = w1; \
          if (F.tid < 256) *(LAS u32x4*)(vl + vtok * SQ_VS + vv8 * 8) = rv; } \
        if ((c) > 0) { const size_t ci = (size_t)(bh * 32 + (c)); \
            _Pragma("unroll") for (int nt = 0; nt < 2; ++nt) { u32x2 w; w.x = pk2(acc[nt][0], acc[nt][1]); w.y = pk2(acc[nt][2], acc[nt][3]); *(u32x2*)(Cc + ci * 32768 + (size_t)(32 * vs + 16 * nt + fr) * 128 + 16 * F.wave + 4 * fq) = w; } \
            if (vs == 0 && fr == 0) *(f32x4*)(NCp + ci * 128 + 16 * F.wave + 4 * fq) = nacc; } \
        __syncthreads(); \
        if ((c) + 4 < 32) { rk0 = *(const u32x4*)(kp + (size_t)((c) + 4) * kcs); rk1 = *(const u32x4*)(kp + (size_t)((c) + 4) * kcs + 32 * 512); rv = *(const u32x4*)(vp + (size_t)((c) + 4) * vcs); } \
        const float dec = sdec[(c)]; \
        acc[0] = acc[0] * dec; acc[1] = acc[1] * dec; nacc = nacc * dec; \
        const unsigned kb = ldsb + SQ_KW + ((c) & 1) * (64 * SQ_KS * 2), vb = ldsb + SQ_VT + ((c) & 1) * (64 * SQ_VS * 2); \
        _Pragma("unroll") for (int ks = 0; ks < 2; ++ks) { const int t0 = 32 * ks + 8 * fq + tr_r; \
            const bf16x8 kf = tr_frag(kb + (unsigned)((t0 * SQ_KS + 16 * F.wave + 4 * tr_c) * 2), kb + (unsigned)(((t0 + 4) * SQ_KS + 16 * F.wave + 4 * tr_c) * 2)); \
            _Pragma("unroll") for (int nt = 0; nt < 2; ++nt) { const bf16x8 vf = tr_frag(vb + (unsigned)((t0 * SQ_VS + 16 * nt + 4 * tr_c) * 2), vb + (unsigned)(((t0 + 4) * SQ_VS + 16 * nt + 4 * tr_c) * 2)); \
                acc[nt] = __builtin_amdgcn_mfma_f32_16x16x32_bf16(kf, vf, acc[nt], 0, 0, 0); } \
            nacc = __builtin_amdgcn_mfma_f32_16x16x32_bf16(kf, ones, nacc, 0, 0, 0); } }
#pragma unroll 1
    for (int c = 0; c < 32; c += 4) { MSEQ_STEP(c, rkA0, rkA1, rvA) MSEQ_STEP(c + 1, rkB0, rkB1, rvB) MSEQ_STEP(c + 2, rkC0, rkC1, rvC) MSEQ_STEP(c + 3, rkD0, rkD1, rvD) }
#undef MSEQ_STEP
    float* Cp = F.out + O_CP + ((size_t)L * 32 + bh) * 32768;
#pragma unroll
    for (int nt = 0; nt < 2; ++nt)
#pragma unroll
        for (int j = 0; j < 4; ++j) Cp[(size_t)(16 * F.wave + 4 * fq + j) * 256 + 32 * vs + 16 * nt + fr] = acc[nt][j];
    if (vs == 0 && fr == 0) *(f32x4*)(F.out + O_NP + ((size_t)L * 32 + bh) * 128 + 16 * F.wave + 4 * fq) = nacc;
    __syncthreads();
}
constexpr int M4_VS = 264;
constexpr int M4_Q = 0, M4_K = 64 * 136 * 2, M4_VT = M4_K + 64 * 136 * 2, M4_CT = M4_VT + 64 * M4_VS * 2, M4_S = M4_CT + 256 * 136 * 2;
__device__ __forceinline__ void m4_item(CArgs& A, Frame& F, int L, int item) {
    const int bh = item >> 5, c = item & 31, b = bh >> 2, h = bh & 3; const int tok0 = b * SEQ + c * 64;
    LAS bf16* qs = (LAS bf16*)(F.lds + M4_Q); LAS bf16* ks_ = (LAS bf16*)(F.lds + M4_K); LAS bf16* vT = (LAS bf16*)(F.lds + M4_VT); LAS bf16* CT = (LAS bf16*)(F.lds + M4_CT);
    LAS float* sa = (LAS float*)(F.lds + M4_S); LAS float* sM = sa + 64; LAS float* sW = sa + 128; LAS float* sE = sa + 192; LAS float* sn = sa + 256; LAS float* red = sa + 384; LAS float* red2 = sa + 512;
    const float* igfg = WSP(float, WS_IGFG);
    if (F.wave == 0) {
        const float m_c = WSP(float, WS_MC)[item];
        const int m = tok0 + F.lane; const float ig = igfg[(size_t)m * 8 + h], fg = igfg[(size_t)m * 8 + 4 + h];
        float bc = log_sigmoid(fg);
#pragma unroll
        for (int o = 1; o < 64; o <<= 1) { const float t = bperm(bc, F.lane - o); if (F.lane >= o) bc += t; }
        const float a = ig - bc; float pm = a;
#pragma unroll
        for (int o = 1; o < 64; o <<= 1) { const float t = bperm(pm, F.lane - o); if (F.lane >= o) pm = fmaxf(pm, t); }
        const float M = fmaxf(m_c, pm);
        sa[F.lane] = a; sM[F.lane] = M; sW[F.lane] = expf(m_c - M); sE[F.lane] = expf(-(bc + M));
    }
    const bf16* Qm = WSP(bf16, WS_QM); const bf16* Km = WSP(bf16, WS_KM); const bf16* Vm = WSP(bf16, WS_VM);
#pragma unroll
    for (int i = 0; i < 2; ++i) { const int idx = F.tid + NT * i, tok = idx >> 4, d8 = idx & 15;
        *(LAS u32x4*)(qs + tok * 136 + d8 * 8) = *(const u32x4*)(Qm + (size_t)(tok0 + tok) * 512 + h * 128 + d8 * 8);
        *(LAS u32x4*)(ks_ + tok * 136 + d8 * 8) = *(const u32x4*)(Km + (size_t)(tok0 + tok) * 512 + h * 128 + d8 * 8); }
    u32x4 rv[4], rc[8];
#pragma unroll
    for (int i = 0; i < 4; ++i) { const int idx = F.tid + NT * i, tok = idx >> 5, v8 = idx & 31; rv[i] = *(const u32x4*)(Vm + (size_t)(tok0 + tok) * 1024 + h * 256 + v8 * 8); }
    if (c > 0) {
        const bf16* Cc = WSP(bf16, WS_CC) + (size_t)item * 32768;
#pragma unroll
        for (int i = 0; i < 8; ++i) { const int idx = F.tid + NT * i, vc = idx >> 4, d8 = idx & 15; rc[i] = *(const u32x4*)(Cc + vc * 128 + d8 * 8); }
        if (F.tid < 128) sn[F.tid] = WSP(float, WS_NC)[(size_t)item * 128 + F.tid];
    } else { if (F.tid < 128) sn[F.tid] = 0.f;
#pragma unroll
        for (int i = 0; i < 8; ++i) rc[i] = (u32x4){0u, 0u, 0u, 0u}; }
    __syncthreads();
    const int fr = F.lane & 15, fq = F.lane >> 4, lt = F.wave & 3, vh = F.wave >> 2, l = 16 * lt + fr;
    bf16x8 qf[4];
#pragma unroll
    for (int ks = 0; ks < 4; ++ks) qf[ks] = *(const LAS bf16x8*)(qs + l * 136 + 32 * ks + 8 * fq);
    const float Ml = sM[l], wl = sW[l];
    float sw[4][4]; float rs = 0.f;
#pragma unroll
    for (int st = 0; st < 4; ++st) {
        f32x4 acc = (f32x4){0.f, 0.f, 0.f, 0.f};
#pragma unroll
        for (int ks = 0; ks < 4; ++ks) { const bf16x8 kf = *(const LAS bf16x8*)(ks_ + (16 * st + fr) * 136 + 32 * ks + 8 * fq); acc = __builtin_amdgcn_mfma_f32_16x16x32_bf16(kf, qf[ks], acc, 0, 0, 0); }
#pragma unroll
        for (int j = 0; j < 4; ++j) { const int s = 16 * st + 4 * fq + j; const float w = (s <= l) ? __expf(sa[s] - Ml) : 0.f; sw[st][j] = acc[j] * w; rs += sw[st][j]; }
    }
    rs += bperm(rs, F.lane ^ 16); rs += bperm(rs, F.lane ^ 32);
    float qn = 0.f;
#pragma unroll
    for (int ks = 0; ks < 4; ++ks)
#pragma unroll
        for (int e = 0; e < 8; ++e) qn += bf2f((unsigned short)qf[ks][e]) * sn[32 * ks + 8 * fq + e];
    qn += bperm(qn, F.lane ^ 16); qn += bperm(qn, F.lane ^ 32);
    const float den = rs + wl * qn; const float inv = 1.0f / fmaxf(fabsf(den), sE[l]);
    bf16x8 pf[2], qsf[4];
#pragma unroll
    for (int k2 = 0; k2 < 2; ++k2) { u32x4 w; w.x = pk2(sw[2 * k2][0], sw[2 * k2][1]); w.y = pk2(sw[2 * k2][2], sw[2 * k2][3]); w.z = pk2(sw[2 * k2 + 1][0], sw[2 * k2 + 1][1]); w.w = pk2(sw[2 * k2 + 1][2], sw[2 * k2 + 1][3]);
        pf[k2] = __builtin_bit_cast(bf16x8, w); }
#pragma unroll
    for (int ks = 0; ks < 4; ++ks) { u32x4 w;
        w.x = pk2(bf2f((unsigned short)qf[ks][0]) * wl, bf2f((unsigned short)qf[ks][1]) * wl); w.y = pk2(bf2f((unsigned short)qf[ks][2]) * wl, bf2f((unsigned short)qf[ks][3]) * wl);
        w.z = pk2(bf2f((unsigned short)qf[ks][4]) * wl, bf2f((unsigned short)qf[ks][5]) * wl); w.w = pk2(bf2f((unsigned short)qf[ks][6]) * wl, bf2f((unsigned short)qf[ks][7]) * wl);
        qsf[ks] = __builtin_bit_cast(bf16x8, w); }
#pragma unroll
    for (int i = 0; i < 4; ++i) { const int idx = F.tid + NT * i, tok = idx >> 5, v8 = idx & 31; *(LAS u32x4*)(vT + tok * M4_VS + v8 * 8) = rv[i]; }
#pragma unroll
    for (int i = 0; i < 8; ++i) { const int idx = F.tid + NT * i, vc = idx >> 4, d8 = idx & 15; *(LAS u32x4*)(CT + vc * 136 + d8 * 8) = rc[i]; }
    u32x2 ogv[8];
    { const bf16* og_ = WSP(bf16, WS_OG) + (size_t)(tok0 + 16 * (F.wave & 3) + (F.lane & 15)) * D + h * 256;
#pragma unroll
      for (int nt = 0; nt < 8; ++nt) ogv[nt] = *(const u32x2*)(og_ + 128 * (F.wave >> 2) + 16 * nt + 4 * (F.lane >> 4)); }
    __syncthreads();
    f32x4 hv[8]; float s1 = 0.f; const unsigned vtb = lds_addr(F.lds) + M4_VT;
#pragma unroll
    for (int nt = 0; nt < 8; ++nt) {
        const int vrow = 128 * vh + 16 * nt + fr;
        f32x4 acc = (f32x4){0.f, 0.f, 0.f, 0.f};
#pragma unroll
        for (int k2 = 0; k2 < 2; ++k2) { const int T0 = 32 * k2 + 4 * fq + ((F.lane & 15) >> 2); const unsigned cb = (unsigned)((128 * vh + 16 * nt + 4 * (F.lane & 3)) * 2);
            const bf16x8 vf = tr_frag(vtb + (unsigned)(T0 * M4_VS * 2) + cb, vtb + (unsigned)((T0 + 16) * M4_VS * 2) + cb);
            acc = __builtin_amdgcn_mfma_f32_16x16x32_bf16(vf, pf[k2], acc, 0, 0, 0); }
#pragma unroll
        for (int ks = 0; ks < 4; ++ks) { const bf16x8 cf = *(const LAS bf16x8*)(CT + vrow * 136 + 32 * ks + 8 * fq); acc = __builtin_amdgcn_mfma_f32_16x16x32_bf16(cf, qsf[ks], acc, 0, 0, 0); }
        hv[nt] = acc * inv; s1 += (hv[nt][0] + hv[nt][1]) + (hv[nt][2] + hv[nt][3]);
    }
    s1 += bperm(s1, F.lane ^ 16); s1 += bperm(s1, F.lane ^ 32);
    if (fq == 0) red[l * 2 + vh] = s1;
    __syncthreads();
    const float mean = (red[l * 2] + red[l * 2 + 1]) * (1.f / 256.f); float s2 = 0.f;
#pragma unroll
    for (int nt = 0; nt < 8; ++nt) { hv[nt] = hv[nt] - mean; s2 += (hv[nt][0] * hv[nt][0] + hv[nt][1] * hv[nt][1]) + (hv[nt][2] * hv[nt][2] + hv[nt][3] * hv[nt][3]); }
    s2 += bperm(s2, F.lane ^ 16); s2 += bperm(s2, F.lane ^ 32);
    if (fq == 0) red2[l * 2 + vh] = s2;
    __syncthreads();
    const float rstd = 1.0f / sqrtf((red2[l * 2] + red2[l * 2 + 1]) * (1.f / 256.f) + LN_EPS);
    const float* gain = A.in[11] + (size_t)L * D + h * 256; bf16* ya = WSP(bf16, WS_YA) + (size_t)(tok0 + l) * D + h * 256;
#pragma unroll
    for (int nt = 0; nt < 8; ++nt) { const int vc = 128 * vh + 16 * nt + 4 * fq;
        const f32x4 g = *(const f32x4*)(gain + vc); const u32x2 o = ogv[nt];
        u32x2 w; w.x = pk2(hv[nt][0] * rstd * g[0] * bflo(o.x), hv[nt][1] * rstd * g[1] * bfhi(o.x)); w.y = pk2(hv[nt][2] * rstd * g[2] * bflo(o.y), hv[nt][3] * rstd * g[3] * bfhi(o.y));
        *(u32x2*)(ya + vc) = w; }
    __syncthreads();
}

constexpr int MS_Q = 0, MS_K = 2048, MS_V = 4096, MS_S = 8192, MS_RED = 8704;
constexpr int MS_LN = MS_RED + 32768;
__device__ __forceinline__ void ms_item(CArgs& A, Frame& F, int L, int item) {
    const int b = item >> 2, h = item & 3; const int tok0 = TP + b * 4;
    LAS float* sq = (LAS float*)(F.lds + MS_Q); LAS float* sk = (LAS float*)(F.lds + MS_K); LAS float* sv = (LAS float*)(F.lds + MS_V); LAS float* sS = (LAS float*)(F.lds + MS_S);
    LAS float* red = (LAS float*)(F.lds + MS_RED); LAS float* lnb = (LAS float*)(F.lds + MS_LN);
    const size_t sidx = ((size_t)L * 128 + b) * 4 + h;
    const float* C0 = A.in[2] + sidx * 32768; const float* n0 = A.in[3] + sidx * 128; const float m0 = A.in[4][sidx];
    const bf16* Qm = WSP(bf16, WS_QM); const bf16* Km = WSP(bf16, WS_KM); const bf16* Vm = WSP(bf16, WS_VM); const float* igfg = WSP(float, WS_IGFG);
    { const int t = F.tid >> 7, d = F.tid & 127; sq[F.tid] = bf2f(Qm[(size_t)(tok0 + t) * 512 + h * 128 + d]); sk[F.tid] = bf2f(Km[(size_t)(tok0 + t) * 512 + h * 128 + d]); }
#pragma unroll
    for (int i = 0; i < 2; ++i) { const int idx = F.tid + NT * i, t = idx >> 8, vc = idx & 255; sv[idx] = bf2f(Vm[(size_t)(tok0 + t) * 1024 + h * 256 + vc]); }
    float ig[4], bc[4], a[4], M[4], wint[4], elim[4], ksc[4];
    { float run = 0.f, pm = -INFINITY;
#pragma unroll
      for (int t = 0; t < 4; ++t) { ig[t] = igfg[(size_t)(tok0 + t) * 8 + h]; run += log_sigmoid(igfg[(size_t)(tok0 + t) * 8 + 4 + h]); bc[t] = run; a[t] = ig[t] - run; pm = fmaxf(pm, a[t]);
          M[t] = fmaxf(m0, pm); wint[t] = expf(m0 - M[t]); elim[t] = expf(-(run + M[t])); } }
    const float bend = bc[3]; float gmax = -INFINITY;
#pragma unroll
    for (int t = 0; t < 4; ++t) gmax = fmaxf(gmax, ig[t] + bend - bc[t]);
    const float mnew = fmaxf(bend + m0, gmax), decay = expf(bend + m0 - mnew);
#pragma unroll
    for (int t = 0; t < 4; ++t) ksc[t] = expf(ig[t] + bend - bc[t] - mnew);
    __syncthreads();
    for (int p = F.wave; p < 20; p += NW) {
        float s;
        if (p < 16) { const int t = p >> 2, s_ = p & 3; s = sq[t * 128 + F.lane] * sk[s_ * 128 + F.lane] + sq[t * 128 + 64 + F.lane] * sk[s_ * 128 + 64 + F.lane]; }
        else { const int t = p - 16; s = sq[t * 128 + F.lane] * n0[F.lane] + sq[t * 128 + 64 + F.lane] * n0[64 + F.lane]; }
        s = wave_sum(s);
        if (F.lane == 0) sS[p] = s;
    }
    __syncthreads();
    const int v4 = (F.tid & 63) * 4, dg = F.tid >> 6;
    f32x4 qc[4]; f32x4 vs4[4];
#pragma unroll
    for (int t = 0; t < 4; ++t) { qc[t] = (f32x4){0.f, 0.f, 0.f, 0.f}; vs4[t] = *(const LAS f32x4*)(sv + t * 256 + v4); }
    float* Cout = F.out + O_CS + sidx * 32768;
    f32x4 c0a[16];
#pragma unroll
    for (int dd = 0; dd < 16; ++dd) c0a[dd] = __builtin_nontemporal_load((const f32x4*)(C0 + (16 * dg + dd) * 256 + v4));
#pragma unroll
    for (int dd = 0; dd < 16; ++dd) { const int d = 16 * dg + dd;
        const f32x4 c0 = c0a[dd]; f32x4 cn = c0 * decay;
#pragma unroll
        for (int t = 0; t < 4; ++t) { qc[t] += c0 * sq[t * 128 + d]; cn += vs4[t] * (sk[t * 128 + d] * ksc[t]); }
        __builtin_nontemporal_store(cn, (f32x4*)(Cout + d * 256 + v4)); }
#pragma unroll
    for (int t = 0; t < 4; ++t) *(LAS f32x4*)(red + (dg * 4 + t) * 256 + v4) = qc[t];
    if (F.tid >= 256 && F.tid < 384) { const int d = F.tid - 256; float nn = n0[d] * decay;
#pragma unroll
        for (int t = 0; t < 4; ++t) nn += sk[t * 128 + d] * ksc[t];
        F.out[O_NS + sidx * 128 + d] = nn; }
    if (F.tid == 0) F.out[O_MS + sidx] = mnew;
    __syncthreads();
    float hval[4];
    if (F.tid < 256) { const int vc = F.tid;
#pragma unroll
        for (int t = 0; t < 4; ++t) { float qC = 0.f;
#pragma unroll
            for (int g = 0; g < 8; ++g) qC += red[(g * 4 + t) * 256 + vc];
            float num = wint[t] * qC, den = wint[t] * sS[16 + t];
#pragma unroll
            for (int s = 0; s < 4; ++s) if (s <= t) { const float w = sS[t * 4 + s] * expf(a[s] - M[t]); num += w * sv[s * 256 + vc]; den += w; }
            hval[t] = num / fmaxf(fabsf(den), elim[t]);
            const float ws = wave_sum(hval[t]); if (F.lane == 0) lnb[t * 4 + F.wave] = ws; }
    }
    __syncthreads();
    float mean[4];
    if (F.tid < 256) {
#pragma unroll
        for (int t = 0; t < 4; ++t) { mean[t] = (lnb[t * 4] + lnb[t * 4 + 1] + lnb[t * 4 + 2] + lnb[t * 4 + 3]) * (1.f / 256.f); hval[t] -= mean[t];
            const float ws = wave_sum(hval[t] * hval[t]); if (F.lane == 0) lnb[16 + t * 4 + F.wave] = ws; }
    }
    __syncthreads();
    if (F.tid < 256) { const int vc = F.tid; const float gain = A.in[11][(size_t)L * D + h * 256 + vc];
#pragma unroll
        for (int t = 0; t < 4; ++t) { const float var = (lnb[16 + t * 4] + lnb[16 + t * 4 + 1] + lnb[16 + t * 4 + 2] + lnb[16 + t * 4 + 3]) * (1.f / 256.f);
            const float rstd = 1.0f / sqrtf(var + LN_EPS); const size_t o = (size_t)(tok0 + t) * D + h * 256 + vc;
            WSP(bf16, WS_YA)[o] = (bf16)f2bf(hval[t] * rstd * gain * bf2f(WSP(bf16, WS_OG)[o])); }
    }
    __syncthreads();
}

constexpr int SW_K = 0, SW_VT = 256 * 72 * 2, SW_BT = SW_VT + 272 * 72 * 2, SW_WAVE = SW_BT + 16 * 132 * 4;
__device__ __forceinline__ void swa_build_bias(CArgs& A, Frame& F) {
    LAS float* bt = (LAS float*)(F.lds + SW_BT); const float* rel = A.in[15];
    for (int i = F.tid; i < 16 * 132; i += NT) { const int h = i / 132, dist = i % 132; bt[i] = rel[RELB[dist] * 16 + h]; }
}
__device__ __forceinline__ void swa_item(CArgs& A, Frame& F, int L, int item) {
    const int b = item >> 6, blk = (item >> 2) & 15, kvh = item & 3;
    LAS bf16* Kl = (LAS bf16*)(F.lds + SW_K); LAS bf16* VT = (LAS bf16*)(F.lds + SW_VT); const LAS float* bt = (const LAS float*)(F.lds + SW_BT);
    const bf16* Ks = WSP(bf16, WS_KS); const bf16* Vs = WSP(bf16, WS_VS); const bf16* Qs = WSP(bf16, WS_QS); bf16* yb = WSP(bf16, WS_YB);
    bf16x8 qn[2];
    const bf16* qbase = Qs + ((size_t)b * SEQ + blk * 128 + 64 * (F.wave >> 2) + (F.lane & 15)) * D + (kvh * 4 + (F.wave & 3)) * 64 + 8 * (F.lane >> 4);
    qn[0] = *(const bf16x8*)qbase; qn[1] = *(const bf16x8*)(qbase + 32);
#pragma unroll
    for (int i = 0; i < 4; ++i) { const int idx = F.tid + NT * i, key = idx >> 3, d8 = idx & 7; const int tr = (blk - 1) * 128 + key;
        u32x4 raw = (u32x4){0u, 0u, 0u, 0u}; if (tr >= 0) raw = *(const u32x4*)(Ks + (size_t)(b * SEQ + tr) * 256 + kvh * 64 + d8 * 8);
        *(LAS u32x4*)(Kl + key * 72 + d8 * 8) = raw; }
#pragma unroll
    for (int i = 0; i < 4; ++i) { const int idx = F.tid + NT * i, key = idx >> 3, d8 = idx & 7; const int tr = (blk - 1) * 128 + key;
        u32x4 raw = (u32x4){0u, 0u, 0u, 0u}; if (tr >= 0) raw = *(const u32x4*)(Vs + (size_t)(b * SEQ + tr) * 256 + kvh * 64 + d8 * 8);
        *(LAS u32x4*)(VT + key * 72 + d8 * 8) = raw; }
    if (F.tid < 16 * 9) { unsigned zz = 0u; asm volatile("" : "+v"(zz)); *(LAS u32x4*)(VT + (256 + F.tid / 9) * 72 + (F.tid % 9) * 8) = (u32x4){zz, zz, zz, zz}; }
    __syncthreads();
    const int fr = F.lane & 15, fq = F.lane >> 4, g2 = F.wave & 3, qh = F.wave >> 2, hq = kvh * 4 + g2, q0 = 64 * qh;
    const float sink = A.in[16][L * 16 + hq]; const unsigned vtb = lds_addr(F.lds) + SW_VT;
    float bias[9][4];
#pragma unroll
    for (int st = 0; st < 9; ++st)
#pragma unroll
        for (int j = 0; j < 4; ++j) { const int srel = 16 * st + 4 * fq + j; const int dist = fr + 128 - srel; bias[st][j] = ((srel >= fr) && (dist >= 0)) ? bt[hq * 132 + (dist < 0 ? 0 : dist)] : -INFINITY; }
#define SWA_TILES(M0_) \
    _Pragma("unroll 1") \
    for (int lt = 0; lt < 4; ++lt) { \
        const int kbase = q0 + 16 * lt; const size_t m = (size_t)b * SEQ + blk * 128 + kbase + fr; \
        bf16x8 qf[2]; qf[0] = qn[0]; qf[1] = qn[1]; \
        if (lt < 3) { qn[0] = *(const bf16x8*)(qbase + (size_t)(16 * (lt + 1)) * D); qn[1] = *(const bf16x8*)(qbase + (size_t)(16 * (lt + 1)) * D + 32); } \
        float sv[9][4]; float mx = -INFINITY; \
    _Pragma("unroll") \
        for (int st = 0; st < 9; ++st) { \
            f32x4 acc = (f32x4){0.f, 0.f, 0.f, 0.f}; \
    _Pragma("unroll") \
            for (int ks = 0; ks < 2; ++ks) { const bf16x8 kf = *(const LAS bf16x8*)(Kl + (kbase + 16 * st + fr) * 72 + 32 * ks + 8 * fq); acc = __builtin_amdgcn_mfma_f32_16x16x32_bf16(kf, qf[ks], acc, 0, 0, 0); } \
    _Pragma("unroll") \
            for (int j = 0; j < 4; ++j) { float x = acc[j] + bias[st][j]; \
                if (M0_) { const int srel = 16 * st + 4 * fq + j; x = (kbase + srel >= 128) ? x : -INFINITY; } \
                sv[st][j] = x; mx = fmaxf(mx, x); } \
        } \
        mx = fmaxf(mx, bperm(mx, F.lane ^ 16)); mx = fmaxf(mx, bperm(mx, F.lane ^ 32)); mx = fmaxf(mx, sink); \
        const float mxl = mx * LOG2E; float sum = 0.f; \
    _Pragma("unroll") \
        for (int st = 0; st < 9; ++st) \
    _Pragma("unroll") \
            for (int j = 0; j < 4; ++j) { const float p = __builtin_amdgcn_exp2f(__builtin_fmaf(sv[st][j], LOG2E, -mxl)); sv[st][j] = p; sum += p; } \
        sum += bperm(sum, F.lane ^ 16); sum += bperm(sum, F.lane ^ 32); \
        const float inv = 1.0f / (sum + __builtin_amdgcn_exp2f(__builtin_fmaf(sink, LOG2E, -mxl))); \
        f32x4 o[4]; \
    _Pragma("unroll") \
        for (int nt = 0; nt < 4; ++nt) o[nt] = (f32x4){0.f, 0.f, 0.f, 0.f}; \
    _Pragma("unroll") \
        for (int k2 = 0; k2 < 5; ++k2) { \
            u32x4 pw; pw.x = pk2(sv[2 * k2][0], sv[2 * k2][1]); pw.y = pk2(sv[2 * k2][2], sv[2 * k2][3]); \
            if (k2 < 4) { pw.z = pk2(sv[2 * k2 + 1 > 8 ? 8 : 2 * k2 + 1][0], sv[2 * k2 + 1 > 8 ? 8 : 2 * k2 + 1][1]); pw.w = pk2(sv[2 * k2 + 1 > 8 ? 8 : 2 * k2 + 1][2], sv[2 * k2 + 1 > 8 ? 8 : 2 * k2 + 1][3]); } else { pw.z = 0u; pw.w = 0u; } \
            const bf16x8 pf = __builtin_bit_cast(bf16x8, pw); \
            { const int T0 = kbase + 32 * k2 + 4 * fq + ((F.lane & 15) >> 2); const unsigned a0 = vtb + (unsigned)((T0 * 72 + 4 * (F.lane & 3)) * 2); \
              bf16x8 vf[4]; tr_frag4(a0, a0 + 16 * 72 * 2, 32u, vf); \
    _Pragma("unroll") \
              for (int nt = 0; nt < 4; ++nt) o[nt] = __builtin_amdgcn_mfma_f32_16x16x32_bf16(vf[nt], pf, o[nt], 0, 0, 0); } \
        } \
    _Pragma("unroll") \
        for (int nt = 0; nt < 4; ++nt) { u32x2 w; w.x = pk2(o[nt][0] * inv, o[nt][1] * inv); w.y = pk2(o[nt][2] * inv, o[nt][3] * inv); \
            *(u32x2*)(yb + m * D + hq * 64 + 16 * nt + 4 * fq) = w; } \
    }
    if (blk == 0) { SWA_TILES(true) } else { SWA_TILES(false) }
#undef SWA_TILES
    __syncthreads();
}
constexpr int SS_K = 0, SS_V = SW_BT + 16 * 132 * 4;
__device__ __forceinline__ void swa_sample_wg(CArgs& A, Frame& F, int L, int item) {
    const int b = item >> 1, kp = item & 1; const int tok0 = TP + b * 4;
    LAS bf16* Kl = (LAS bf16*)(F.lds + SS_K); LAS bf16* Vl = (LAS bf16*)(F.lds + SS_V); const LAS float* bt = (const LAS float*)(F.lds + SW_BT);
    const bf16* Ks = WSP(bf16, WS_KS); const bf16* Vs = WSP(bf16, WS_VS); const bf16* Qs = WSP(bf16, WS_QS); bf16* yb = WSP(bf16, WS_YB);
    const size_t so = ((size_t)L * 128 + b) * 32768 + kp * 128;
    const float* bk = A.in[5] + so; const float* bv = A.in[6] + so; float* dk = F.out + O_KS + so; float* dv = F.out + O_VS + so;
    const int fr = F.lane & 15, fq = F.lane >> 4, hq = 8 * kp + F.wave, kvl = F.wave >> 2;
    bf16x8 qf[2];
    { const bf16* qb = Qs + (size_t)(tok0 + (fr & 3)) * D + hq * 64 + 8 * fq; qf[0] = *(const bf16x8*)qb; qf[1] = *(const bf16x8*)(qb + 32); }
    f32x4 rk[8], rv[8];
#pragma unroll
    for (int i = 0; i < 8; ++i) { const int idx = F.tid + NT * i, key = idx >> 5, c4 = idx & 31; rk[i] = __builtin_nontemporal_load((const f32x4*)(bk + key * 256 + 4 * c4)); }
#pragma unroll
    for (int i = 0; i < 8; ++i) { const int idx = F.tid + NT * i, key = idx >> 5, c4 = idx & 31; rv[i] = __builtin_nontemporal_load((const f32x4*)(bv + key * 256 + 4 * c4)); }
    if (F.tid < 128) { const int t = F.tid & 63, jj = t >> 4, seg = t & 15; const bf16* src = (F.tid < 64 ? Ks : Vs) + (size_t)(tok0 + jj) * 256 + kp * 128 + 8 * seg;
        LAS bf16* dst = (F.tid < 64 ? Kl : Vl) + ((seg >> 3) * (F.tid < 64 ? 144 : 160) + 128 + jj) * 72 + 8 * (seg & 7);
        *(LAS u32x4*)dst = *(const u32x4*)src; }
    else { const int t = F.tid - 128;
        unsigned zz = 0u; asm volatile("" : "+v"(zz));
        for (int q = t; q < 504; q += NT - 128) { const int rr = q / 9, pc = q % 9; *(LAS u32x4*)(Vl + ((rr / 28) * 160 + 132 + (rr % 28)) * 72 + 8 * pc) = (u32x4){zz, zz, zz, zz}; } }
#pragma unroll
    for (int i = 0; i < 8; ++i) { const int idx = F.tid + NT * i, key = idx >> 5, c4 = idx & 31;
        if (key >= 4) __builtin_nontemporal_store(rk[i], (f32x4*)(dk + (key - 4) * 256 + 4 * c4));
        u32x2 w; w.x = pk2(rk[i][0], rk[i][1]); w.y = pk2(rk[i][2], rk[i][3]); *(LAS u32x2*)(Kl + ((c4 >> 4) * 144 + key) * 72 + 4 * (c4 & 15)) = w; }
#pragma unroll
    for (int i = 0; i < 8; ++i) { const int idx = F.tid + NT * i, key = idx >> 5, c4 = idx & 31;
        if (key >= 4) __builtin_nontemporal_store(rv[i], (f32x4*)(dv + (key - 4) * 256 + 4 * c4));
        u32x2 w; w.x = pk2(rv[i][0], rv[i][1]); w.y = pk2(rv[i][2], rv[i][3]); *(LAS u32x2*)(Vl + ((c4 >> 4) * 160 + key) * 72 + 4 * (c4 & 15)) = w; }
    __syncthreads();
    const float sink = A.in[16][L * 16 + hq]; const LAS bf16* Kh = Kl + kvl * 144 * 72; const unsigned vtb = lds_addr(F.lds) + SS_V + (unsigned)(kvl * 160 * 72 * 2);
    float sv[9][4]; float mx = -INFINITY;
#pragma unroll
    for (int st = 0; st < 9; ++st) {
        f32x4 acc = (f32x4){0.f, 0.f, 0.f, 0.f};
#pragma unroll
        for (int ks = 0; ks < 2; ++ks) { const bf16x8 kf = *(const LAS bf16x8*)(Kh + (16 * st + fr) * 72 + 32 * ks + 8 * fq); acc = __builtin_amdgcn_mfma_f32_16x16x32_bf16(kf, qf[ks], acc, 0, 0, 0); }
#pragma unroll
        for (int j = 0; j < 4; ++j) { const int srel = 16 * st + 4 * fq + j; const int dist = fr + 128 - srel;
            const bool valid = (srel >= fr) && (dist >= 0);
            sv[st][j] = valid ? acc[j] + bt[hq * 132 + (dist < 0 ? 0 : (dist > 128 ? 128 : dist))] : -INFINITY; mx = fmaxf(mx, sv[st][j]); }
    }
    mx = fmaxf(mx, bperm(mx, F.lane ^ 16)); mx = fmaxf(mx, bperm(mx, F.lane ^ 32)); mx = fmaxf(mx, sink);
    const float mxl = mx * LOG2E; float sum = 0.f;
#pragma unroll
    for (int st = 0; st < 9; ++st)
#pragma unroll
        for (int j = 0; j < 4; ++j) { const float p = __builtin_amdgcn_exp2f(__builtin_fmaf(sv[st][j], LOG2E, -mxl)); sv[st][j] = p; sum += p; }
    sum += bperm(sum, F.lane ^ 16); sum += bperm(sum, F.lane ^ 32);
    const float inv = 1.0f / (sum + __builtin_amdgcn_exp2f(__builtin_fmaf(sink, LOG2E, -mxl)));
    f32x4 o[4];
#pragma unroll
    for (int nt = 0; nt < 4; ++nt) o[nt] = (f32x4){0.f, 0.f, 0.f, 0.f};
#pragma unroll
    for (int k2 = 0; k2 < 5; ++k2) {
        u32x4 pw; pw.x = pk2(sv[2 * k2][0], sv[2 * k2][1]); pw.y = pk2(sv[2 * k2][2], sv[2 * k2][3]);
        if (k2 < 4) { pw.z = pk2(sv[2 * k2 + 1 > 8 ? 8 : 2 * k2 + 1][0], sv[2 * k2 + 1 > 8 ? 8 : 2 * k2 + 1][1]); pw.w = pk2(sv[2 * k2 + 1 > 8 ? 8 : 2 * k2 + 1][2], sv[2 * k2 + 1 > 8 ? 8 : 2 * k2 + 1][3]); } else { pw.z = 0u; pw.w = 0u; }
        const bf16x8 pf = __builtin_bit_cast(bf16x8, pw);
        { const int T0 = 32 * k2 + 4 * fq + ((F.lane & 15) >> 2); const unsigned a0 = vtb + (unsigned)((T0 * 72 + 4 * (F.lane & 3)) * 2);
          bf16x8 vf[4]; tr_frag4(a0, a0 + 16 * 72 * 2, 32u, vf);
#pragma unroll
          for (int nt = 0; nt < 4; ++nt) o[nt] = __builtin_amdgcn_mfma_f32_16x16x32_bf16(vf[nt], pf, o[nt], 0, 0, 0); }
    }
    if (fr < 4) {
#pragma unroll
        for (int nt = 0; nt < 4; ++nt) { u32x2 w; w.x = pk2(o[nt][0] * inv, o[nt][1] * inv); w.y = pk2(o[nt][2] * inv, o[nt][3] * inv);
            *(u32x2*)(yb + (size_t)(tok0 + fr) * D + hq * 64 + 16 * nt + 4 * fq) = w; } }
    __syncthreads();
}

constexpr int RW_STRIDE = 1032, RW_LO = 36 * RW_STRIDE * 2;
__device__ __forceinline__ void ln1_router_phase(CArgs& A, Frame& F, int L) {
    LAS bf16* Wh = (LAS bf16*)F.lds; LAS bf16* Wl = (LAS bf16*)(F.lds + RW_LO);
    { const u32x4* srcw = (const u32x4*)(F.ws + WS_RW);
#pragma unroll 6
      for (int i = F.tid; i < 2 * 36 * RW_STRIDE * 2 / 16; i += NT) *(LAS u32x4*)(F.lds + 16 * i) = srcw[i]; }
    if (F.tid < 32) F.LW[LW_CNT + F.tid] = 0u;
    const int rpw = (T + F.G - 1) / F.G, r0 = F.bid * rpw, r1 = (r0 + rpw < T) ? r0 + rpw : T;
    const float* g = A.in[17] + ((size_t)L * 3 + 0) * D; const float* bb = A.in[18] + ((size_t)L * 3 + 0) * D;
    const float* b_rg = A.in[20] + L * 4; const float* b_re = A.in[22] + L * 32;
    bf16* X = WSP(bf16, WS_X); int* asg = WSP(int, WS_ASG); float* gate = WSP(float, WS_GATE);
    { u32x4 na[2], nb[2]; const int mf = r0 + 2 * F.wave;
      if (mf < r1) { row_raw(X + (size_t)mf * D, F.lane, na); row_raw(X + (size_t)((mf + 1 < r1) ? mf + 1 : mf) * D, F.lane, nb); }
      for (int m = mf; m < r1; m += 2 * NW) { const int mb = (m + 1 < r1) ? m + 1 : m; f32x4 va[4], vb[4];
        row_unpack(na, va); row_unpack(nb, vb);
        { const int mn = m + 2 * NW; if (mn < r1) { row_raw(X + (size_t)mn * D, F.lane, na); row_raw(X + (size_t)((mn + 1 < r1) ? mn + 1 : mn) * D, F.lane, nb); } }
        row_ln(va, g, bb, F.lane); row_ln(vb, g, bb, F.lane);
        row_store_bf(X + (size_t)m * D, F.lane, va); row_store_bf(X + (size_t)mb * D, F.lane, vb); } }
    VM_WAIT(); __syncthreads();
    const int ntile = (r1 - r0 + 15) >> 4; const int fr = F.lane & 15, fq = F.lane >> 4;
    float* LG = WSP(float, WS_LG);
    for (int tile = F.wave; tile < ntile; tile += NW) {
        f32x4 lacc[3] = {(f32x4){0.f, 0.f, 0.f, 0.f}, (f32x4){0.f, 0.f, 0.f, 0.f}, (f32x4){0.f, 0.f, 0.f, 0.f}};
        const int trow = (r0 + 16 * tile + fr < r1) ? r0 + 16 * tile + fr : r1 - 1;
        const bf16* xr = X + (size_t)trow * D + 8 * fq;
        int orow[3];
#pragma unroll
        for (int nt = 0; nt < 3; ++nt) orow[nt] = ((16 * nt + fr < 36) ? 16 * nt + fr : 35) * RW_STRIDE + 8 * fq;
#pragma unroll 1
        for (int half = 0; half < 2; ++half) {
            bf16x8 af[16];
#pragma unroll
            for (int ks = 0; ks < 16; ++ks) af[ks] = *(const bf16x8*)(xr + 32 * (16 * half + ks));
#pragma unroll
            for (int ks = 0; ks < 16; ++ks)
#pragma unroll
                for (int nt = 0; nt < 3; ++nt) { const int off = orow[nt] + 32 * (16 * half + ks);
                    const bf16x8 bh = *(const LAS bf16x8*)(Wh + off), bl = *(const LAS bf16x8*)(Wl + off);
                    lacc[nt] = __builtin_amdgcn_mfma_f32_16x16x32_bf16(bh, af[ks], lacc[nt], 0, 0, 0);
                    lacc[nt] = __builtin_amdgcn_mfma_f32_16x16x32_bf16(bl, af[ks], lacc[nt], 0, 0, 0); } }
        if (r0 + 16 * tile + fr < r1) {
#pragma unroll
            for (int nt = 0; nt < 3; ++nt) *(f32x4*)(LG + (size_t)trow * 48 + 16 * nt + 4 * fq) = lacc[nt]; }
    }
    VM_WAIT(); __syncthreads();
    for (int m = r0 + F.tid; m < r1; m += NT) { const float* lr = LG + (size_t)m * 48;
        float gl[4]; int gi = 0;
        { const f32x4 x = *(const f32x4*)lr; gl[0] = x[0] + b_rg[0]; gl[1] = x[1] + b_rg[1]; gl[2] = x[2] + b_rg[2]; gl[3] = x[3] + b_rg[3]; }
        float gmax = gl[0];
#pragma unroll
        for (int c = 1; c < 4; ++c) if (gl[c] > gmax) { gmax = gl[c]; gi = c; }
        float gs = 0.f;
#pragma unroll
        for (int c = 0; c < 4; ++c) gs += expf(gl[c] - gmax);
        const float gw_ = 1.0f / gs;
        float el[8];
        { const f32x4 x = *(const f32x4*)(lr + 4 + 8 * gi), y = *(const f32x4*)(lr + 8 + 8 * gi); const f32x4 bx = *(const f32x4*)(b_re + 8 * gi), by = *(const f32x4*)(b_re + 8 * gi + 4);
          el[0] = x[0] + bx[0]; el[1] = x[1] + bx[1]; el[2] = x[2] + bx[2]; el[3] = x[3] + bx[3]; el[4] = y[0] + by[0]; el[5] = y[1] + by[1]; el[6] = y[2] + by[2]; el[7] = y[3] + by[3]; }
        int i1 = 0; float l1 = el[0];
#pragma unroll
        for (int i = 1; i < 8; ++i) if (el[i] > l1) { l1 = el[i]; i1 = i; }
        int i2 = -1; float l2v = -INFINITY;
#pragma unroll
        for (int i = 0; i < 8; ++i) if (i != i1 && el[i] > l2v) { l2v = el[i]; i2 = i; }
        const float e2 = expf(l2v - l1), r = 1.0f / (1.0f + e2);
        const int ea = gi * 8 + i1, eb = gi * 8 + i2;
        const unsigned ra = __hip_atomic_fetch_add((LAS unsigned*)&F.LW[LW_CNT + ea], 1u, __ATOMIC_RELAXED, __HIP_MEMORY_SCOPE_WORKGROUP);
        const unsigned rb = __hip_atomic_fetch_add((LAS unsigned*)&F.LW[LW_CNT + eb], 1u, __ATOMIC_RELAXED, __HIP_MEMORY_SCOPE_WORKGROUP);
        asg[2 * m] = (ea << 24) | (int)ra; asg[2 * m + 1] = (eb << 24) | (int)rb; gate[2 * m] = gw_ * r; gate[2 * m + 1] = gw_ * e2 * r; }
    VM_WAIT(); __syncthreads();
    if (F.tid < 32) { const unsigned c = F.LW[LW_CNT + F.tid]; F.LW[LW_BASE + F.tid] = __hip_atomic_fetch_add(F.ctl + CW_CNT + (L * 32 + F.tid) * 64, c, __ATOMIC_RELAXED, __HIP_MEMORY_SCOPE_AGENT); }
    __syncthreads();
    { bf16* Xg = WSP(bf16, WS_XG); int* slot = WSP(int, WS_SLOT);
      int nag[4]; u32x4 nwa[2], nwb[2];
#define LN1E_LOAD(mq_) do { const int ma_ = (mq_), mb_ = (ma_ + 1 < r1) ? ma_ + 1 : ma_; nag[0] = asg[2 * ma_]; nag[1] = asg[2 * ma_ + 1]; nag[2] = asg[2 * mb_]; nag[3] = asg[2 * mb_ + 1]; \
          row_raw(X + (size_t)ma_ * D, F.lane, nwa); row_raw(X + (size_t)mb_ * D, F.lane, nwb); } while (0)
      if (r0 + 2 * F.wave < r1) LN1E_LOAD(r0 + 2 * F.wave);
      for (int m = r0 + 2 * F.wave; m < r1; m += 2 * NW) { const int mb = (m + 1 < r1) ? m + 1 : m;
        int ag[4]; u32x4 wa[2], wb[2];
#pragma unroll
        for (int q = 0; q < 4; ++q) ag[q] = nag[q];
        wa[0] = nwa[0]; wa[1] = nwa[1]; wb[0] = nwb[0]; wb[1] = nwb[1];
        if (m + 2 * NW < r1) LN1E_LOAD(m + 2 * NW);
        int sl[4];
#pragma unroll
        for (int q = 0; q < 4; ++q) { const int e = (int)((unsigned)ag[q] >> 24), rk = (ag[q] & 0xffffff) + (int)F.LW[LW_BASE + e]; ag[q] = (e << 24) | rk; sl[q] = rk < ECAP ? e * ECAP + rk : -1; }
        if (F.lane == 0) { asg[2 * m] = ag[0]; asg[2 * m + 1] = ag[1]; slot[2 * m] = sl[0]; slot[2 * m + 1] = sl[1];
            if (mb != m) { asg[2 * mb] = ag[2]; asg[2 * mb + 1] = ag[3]; slot[2 * mb] = sl[2]; slot[2 * mb + 1] = sl[3]; } }
#pragma unroll
        for (int j = 0; j < 2; ++j) {
            if (sl[0] >= 0) *(u32x4*)(Xg + (size_t)sl[0] * D + 8 * F.lane + 512 * j) = wa[j]; if (sl[1] >= 0) *(u32x4*)(Xg + (size_t)sl[1] * D + 8 * F.lane + 512 * j) = wa[j];
            if (sl[2] >= 0) *(u32x4*)(Xg + (size_t)sl[2] * D + 8 * F.lane + 512 * j) = wb[j]; if (sl[3] >= 0) *(u32x4*)(Xg + (size_t)sl[3] * D + 8 * F.lane + 512 * j) = wb[j]; }
      }
#undef LN1E_LOAD
    }
}
__device__ __forceinline__ void moe_tables(Frame& F, int L) {
    if (F.wave == 0) {
        const int e = F.lane; unsigned cnt = 0u;
        if (e < 32) cnt = __hip_atomic_load(F.ctl + CW_CNT + (L * 32 + e) * 64, __ATOMIC_RELAXED, __HIP_MEMORY_SCOPE_AGENT);
        const unsigned ovf = (__builtin_amdgcn_ballot_w64(cnt > (unsigned)ECAP) != 0ull) ? 1u : 0u;
        const unsigned np = (cnt + 255u) >> 8; int incl = (int)np;
#pragma unroll
        for (int o = 1; o < 32; o <<= 1) { const int t = __builtin_amdgcn_ds_bpermute((e - o) << 2, incl); if (e >= o) incl += t; }
        const unsigned excl = (unsigned)incl - np;
        if (e < 32) { F.LW[LW_FCNT + e] = cnt; F.LW[LW_PST + e] = excl * 256u;
#pragma unroll 1
            for (unsigned q = 0; q < np; ++q) F.LW[LW_PANE + excl + q] = ((unsigned)e << 16) | (ovf ? excl + q : (unsigned)e * 8u + q); }
        if (e == 31) { F.LW[LW_PST + 32] = (unsigned)incl * 256u; F.LW[LW_NP] = (unsigned)incl; F.LW[LW_OVF] = ovf; }
    }
    __syncthreads();
}
__device__ __forceinline__ void gather_exact(Frame& F) {
    const bf16* X = WSP(bf16, WS_X); bf16* Xg = WSP(bf16, WS_XG); const int* asg = WSP(int, WS_ASG); int* slot = WSP(int, WS_SLOT);
    for (int m = F.gw; m < T; m += F.NGW) {
        const int a0 = asg[2 * m], a1 = asg[2 * m + 1];
        const int s0 = (int)F.LW[LW_PST + ((unsigned)a0 >> 24)] + (a0 & 0xffffff), s1 = (int)F.LW[LW_PST + ((unsigned)a1 >> 24)] + (a1 & 0xffffff);
        if (F.lane == 0) { slot[2 * m] = s0; slot[2 * m + 1] = s1; }
#pragma unroll
        for (int j = 0; j < 4; ++j) { const u32x2 w = *(const u32x2*)(X + (size_t)m * D + 4 * F.lane + 256 * j);
            *(u32x2*)(Xg + (size_t)s0 * D + 4 * F.lane + 256 * j) = w; *(u32x2*)(Xg + (size_t)s1 * D + 4 * F.lane + 256 * j) = w; }
    }
}
__device__ __forceinline__ void ln2_phase(CArgs& A, Frame& F, int L) {
    const float* g = A.in[17] + ((size_t)L * 3 + 1) * D; const float* bb = A.in[18] + ((size_t)L * 3 + 1) * D;
    bf16* X = WSP(bf16, WS_X); const bf16* YS = WSP(bf16, WS_YS); const int* slot = WSP(int, WS_SLOT); const float* gate = WSP(float, WS_GATE);
    int m0, m1; row_range(F, m0, m1);
    for (int c0 = m0; c0 < m1; c0 += 32) { const int c1 = (c0 + 32 < m1) ? c0 + 32 : m1;
        int slv = 0; float gtv = 0.f;
        if (F.lane < 2 * (c1 - c0)) { slv = slot[2 * c0 + F.lane]; gtv = gate[2 * c0 + F.lane]; }
        u32x4 nx[2][3][2];
#define LN2_LOAD(mq_) do { _Pragma("unroll") for (int r = 0; r < 2; ++r) { const int mm_ = ((mq_) + r < c1) ? (mq_) + r : c1 - 1; const int i_ = 2 * (mm_ - c0); \
            const int s0_ = __builtin_amdgcn_readlane(slv, i_), s1_ = __builtin_amdgcn_readlane(slv, i_ + 1); \
            row_raw(X + (size_t)mm_ * D, F.lane, nx[r][0]); row_raw(YS + (size_t)s0_ * D, F.lane, nx[r][1]); row_raw(YS + (size_t)s1_ * D, F.lane, nx[r][2]); } } while (0)
        LN2_LOAD(c0);
        for (int m = c0; m < c1; m += 2) {
            u32x4 cur[2][3][2];
#pragma unroll
            for (int r = 0; r < 2; ++r)
#pragma unroll
                for (int k = 0; k < 3; ++k) { cur[r][k][0] = nx[r][k][0]; cur[r][k][1] = nx[r][k][1]; }
            if (m + 2 < c1) LN2_LOAD(m + 2);
#pragma unroll
            for (int r = 0; r < 2; ++r) { const int mm = (m + r < c1) ? m + r : c1 - 1; const int i_ = 2 * (mm - c0);
                const float g0 = __builtin_bit_cast(float, __builtin_amdgcn_readlane(__builtin_bit_cast(int, gtv), i_)), g1 = __builtin_bit_cast(float, __builtin_amdgcn_readlane(__builtin_bit_cast(int, gtv), i_ + 1));
                f32x4 v[4]; row_unpack(cur[r][0], v);
#pragma unroll
                for (int j2 = 0; j2 < 2; ++j2) { const unsigned a0[4] = {cur[r][1][j2].x, cur[r][1][j2].y, cur[r][1][j2].z, cur[r][1][j2].w}, a1[4] = {cur[r][2][j2].x, cur[r][2][j2].y, cur[r][2][j2].z, cur[r][2][j2].w};
#pragma unroll
                    for (int q = 0; q < 4; ++q) { f32x4& vv = v[2 * j2 + (q >> 1)]; const int i0 = 2 * (q & 1);
                        vv[i0] = vv[i0] * DN_ALPHA + (g0 * bflo(a0[q]) + g1 * bflo(a1[q])); vv[i0 + 1] = vv[i0 + 1] * DN_ALPHA + (g0 * bfhi(a0[q]) + g1 * bfhi(a1[q])); } }
                row_ln(v, g, bb, F.lane);
                row_store_bf(X + (size_t)mm * D, F.lane, v); }
        }
#undef LN2_LOAD
    }
}

constexpr int PH_PER_LAYER = 11, N_PHASES = 1 + DEPTH * PH_PER_LAYER;
__global__ void __launch_bounds__(NT, 2) fwd(const Args args) {
    extern __shared__ __attribute__((aligned(16))) unsigned char lds_raw[];
    Frame F0;
    F0.lds = (LAS unsigned char*)lds_raw; F0.LW = (volatile LAS unsigned*)(F0.lds + LDSCTL_OFF);
    F0.tid = threadIdx.x; F0.lane = F0.tid & 63; F0.wave = __builtin_amdgcn_readfirstlane(F0.tid >> 6); F0.G = gridDim.x; F0.bid = blockIdx.x; F0.gw = blockIdx.x * NW + F0.wave; F0.NGW = F0.G * NW;
    F0.out = nullptr; F0.ws = nullptr; F0.ctl = nullptr;
    for (int u = F0.tid; u < (LDS_BYTES - LDSCTL_OFF) / 4; u += NT) F0.LW[u] = 0u;
    __syncthreads();
    const int lo = args.ph_lo, hi = args.ph_hi;
    const bool multi = (hi - lo) > 1;
    XcdBarrier bar; bar.bar = (unsigned*)(args.ws + WS_CTL) + CW_BAR; bar.x = 0; bar.st = F0.LW + LW_XB;
    if (multi) bar = xcd_barrier_post((unsigned*)(args.ws + WS_CTL) + CW_BAR, F0.LW + LW_XB);
#ifdef PH_ONLY
#define IN(k) (((k) == 0 ? 0 : (((k) - 1) % PH_PER_LAYER) + 1) == PH_ONLY && lo <= (k) && (k) < hi)
#else
#define IN(k) (lo <= (k) && (k) < hi)
#endif
#define SEAM(k) do { if (IN(k) && IN((k) + 1)) { XcdBarrier b_ = bar; asm volatile("" : "+s"(b_.bar)); xcd_barrier(b_); } } while (0)
#define REPEAT(k) for (int rep_ = 0; rep_ < ((k) == REP_SEL ? REP_N : 1); ++rep_)
#define PHASE_BEGIN CArgs* ap_ = (CArgs*)__builtin_amdgcn_kernarg_segment_ptr(); int L = Lrt; asm volatile("" : "+s"(ap_), "+s"(L)); CArgs& A = *ap_; Frame F = F0; F.ws = A.ws; F.out = A.out; F.ctl = (unsigned*)(F.ws + WS_CTL); { unsigned z_ = 0u; asm volatile("" : "+s"(z_)); int l_ = (int)__builtin_amdgcn_mbcnt_hi(~0u, __builtin_amdgcn_mbcnt_lo(~0u, z_)), w_ = F0.wave, b_ = F0.bid; asm volatile("" : "+v"(l_), "+s"(w_), "+s"(b_)); F.tid = w_ * 64 + l_; F.bid = b_; F.lane = l_; F.wave = w_; F.gw = b_ * NW + w_; }

    if (IN(0)) {
        const int Lrt = 0; PHASE_BEGIN
        stage_wig(A, F, 0); __syncthreads();
        { int m0, m1; row_range(F, m0, m1);
          for (int m = m0; m < m1; m += 2) { const int mb = (m + 1 < m1) ? m + 1 : m; f32x4 va[4], vb[4];
              row_load(m < TP ? A.in[0] + (size_t)m * D : A.in[1] + (size_t)(m - TP) * D, F.lane, va); row_load(mb < TP ? A.in[0] + (size_t)mb * D : A.in[1] + (size_t)(mb - TP) * D, F.lane, vb);
              row_finalize(A, F, m, va, 0); row_finalize(A, F, mb, vb, 0); } }
        convert_layer(A, F, 0, 0);
    }
    SEAM(0);
    for (int Lrt = 0; Lrt < DEPTH; ++Lrt) {
        const int pb = 1 + Lrt * PH_PER_LAYER;
        if (IN(pb + 0)) REPEAT(1) { PHASE_BEGIN
            pg8::StaticOrder S; S.init(T / 256, NIN / 256, F.G, F.bid);
            EpiIn E{F.ws, F.out, A.in[10] + (size_t)L * DIN, L};
            pg8::gemm_phase(F.tid, F.lds, WSP(bf16, WS_X), WSW(bf16, WS_WIN, L), D, S, E);
            if (L + 1 < DEPTH) { REFRESH_LANE(F); const int rem = ((T / 256) * (NIN / 256)) % F.G;
                if (rem == 0 || F.bid >= rem) convert_range(A, F, L + 1, CV_D, CV_I, rem == 0 ? F.G : F.G - rem, rem == 0 ? F.bid : F.bid - rem); }
        }
        SEAM(pb + 0);
        if (IN(pb + 1)) REPEAT(2) { PHASE_BEGIN
            swa_build_bias(A, F); __syncthreads();
            if ((F.bid >> 3) & 1) {
                for (int it = F.bid; it < 512; it += F.G) ms_item(A, F, L, it);
                for (int it = F.bid; it < 256; it += F.G) swa_sample_wg(A, F, L, it);
            }
            asm volatile("" : "+v"(F.tid), "+v"(F.lane));
            for (int it = F.bid; it < 512; it += F.G) swa_item(A, F, L, it);
            for (int it = F.bid; it < 256; it += F.G) mseq_item(F, L, it);
            asm volatile("" : "+v"(F.tid), "+v"(F.lane));
            if (!((F.bid >> 3) & 1)) {
                for (int it = F.bid; it < 512; it += F.G) ms_item(A, F, L, it);
                for (int it = F.bid; it < 256; it += F.G) swa_sample_wg(A, F, L, it);
            }
        }
        SEAM(pb + 1);
        if (IN(pb + 2)) REPEAT(4) { PHASE_BEGIN for (int it = F.bid; it < 1024; it += F.G) m4_item(A, F, L, it); }
        SEAM(pb + 2);
        if (IN(pb + 3)) REPEAT(5) { PHASE_BEGIN
            pg8::PairOrder S; S.so.init(TP / 256, 4, F.G, F.bid);
            EpiAB E{EpiF<0>{nullptr, WSP(float, WS_MIXA), WSP(bf16, WS_GA), nullptr, nullptr}, EpiF<1>{nullptr, WSP(float, WS_MIXA), WSP(bf16, WS_GB), WSP(bf16, WS_U), nullptr}};
            pg8::gemm_phase(F.tid, F.lds, WSP(bf16, WS_YA), WSW(bf16, WS_WA, L), D, S, E, WSP(bf16, WS_YB), WSW(bf16, WS_WB, L));
            small_gemm(F, WSP(bf16, WS_YA), WSW(bf16, WS_WA, L), D, E.e0); small_gemm(F, WSP(bf16, WS_YB), WSW(bf16, WS_WB, L), D, E.e1);
        }
        SEAM(pb + 3);
        if (IN(pb + 4)) { PHASE_BEGIN
            pg8::StaticOrder S; S.init(TP / 256, 4, F.G, F.bid);
            EpiF<2> E{WSP(bf16, WS_X), nullptr, nullptr, nullptr, nullptr}; pg8::gemm_phase(F.tid, F.lds, WSP(bf16, WS_U), WSW(bf16, WS_WOUT, L), D, S, E); small_gemm(F, WSP(bf16, WS_U), WSW(bf16, WS_WOUT, L), D, E);
        }
        SEAM(pb + 4);
        if (IN(pb + 5)) { PHASE_BEGIN ln1_router_phase(A, F, L); }
        SEAM(pb + 5);
        if (IN(pb + 6)) REPEAT(9) { PHASE_BEGIN
            moe_tables(F, L);
            if (__builtin_amdgcn_readfirstlane((int)F.LW[LW_OVF]) != 0) { gather_exact(F); XcdBarrier b_ = bar; asm volatile("" : "+s"(b_.bar)); xcd_barrier(b_); }
            asm volatile("" : "+v"(F.tid));
            pg8::MoeOrder S{(const volatile LAS int*)(F.LW + LW_PANE), __builtin_amdgcn_readfirstlane((int)F.LW[LW_NP]), F.G, F.bid};
            EpiGU E{WSP(bf16, WS_H)}; pg8::gemm_phase(F.tid, F.lds, WSP(bf16, WS_XG), WSW(bf16, WS_WGU, L), D, S, E);
            if (L + 1 < DEPTH) { REFRESH_LANE(F); const int rem = (__builtin_amdgcn_readfirstlane((int)F.LW[LW_NP]) * 4) % F.G;
                if (rem == 0 || F.bid >= rem) convert_range(A, F, L + 1, 0, CV_G, rem == 0 ? F.G : F.G - rem, rem == 0 ? F.bid : F.bid - rem); }
        }
        SEAM(pb + 6);
        if (IN(pb + 7)) REPEAT(10) { PHASE_BEGIN
            moe_tables(F, L); asm volatile("" : "+v"(F.tid));
            pg8::MoeOrder S{(const volatile LAS int*)(F.LW + LW_PANE), __builtin_amdgcn_readfirstlane((int)F.LW[LW_NP]), F.G, F.bid};
            EpiDN E{WSP(bf16, WS_YS)}; pg8::gemm_phase(F.tid, F.lds, WSP(bf16, WS_H), WSW(bf16, WS_WD, L), DEXP, S, E);
            { const int nu = __builtin_amdgcn_readfirstlane((int)F.LW[LW_NP]) * 4, rem = nu % F.G; asm volatile("" : "+v"(F.tid));
              if (rem == 0 || F.bid >= rem) { pg8::SubsetOrder S2{(T / 256) * 4, rem == 0 ? F.G : F.G - rem, rem == 0 ? F.bid : F.bid - rem};
                  EpiF<3> E2{nullptr, WSP(float, WS_T2), nullptr, nullptr, nullptr}; pg8::gemm_phase(F.tid, F.lds, WSP(bf16, WS_PB), WSW(bf16, WS_WPP, L), DPLE, S2, E2);
                  if (L + 1 < DEPTH) { REFRESH_LANE(F); convert_range(A, F, L + 1, CV_G, CV_D, rem == 0 ? F.G : F.G - rem, rem == 0 ? F.bid : F.bid - rem); } } }
        }
        SEAM(pb + 7);
        if (IN(pb + 8)) { PHASE_BEGIN ln2_phase(A, F, L); }
        SEAM(pb + 8);
        if (IN(pb + 9)) { PHASE_BEGIN
            pg8::StaticOrder S; S.init(TP / 256, 4, F.G, F.bid);
            { EpiF<4> E{WSP(bf16, WS_X), WSP(float, WS_T2), nullptr, nullptr, WSP(bf16, WS_XB)}; pg8::gemm_phase(F.tid, F.lds, WSP(bf16, WS_X), WSW(bf16, WS_WPG, L), D, S, E); small_gemm(F, WSP(bf16, WS_X), WSW(bf16, WS_WPG, L), D, E); }
        }
        SEAM(pb + 9);
        if (IN(pb + 10)) { PHASE_BEGIN
            const float* g = A.in[17] + ((size_t)L * 3 + 2) * D; const float* bb = A.in[18] + ((size_t)L * 3 + 2) * D; const bf16* X = WSP(bf16, WS_XB);
            if (L + 1 < DEPTH) { stage_wig(A, F, L + 1); __syncthreads(); }
            int m0, m1; row_range(F, m0, m1);
            for (int m = m0; m < m1; m += 4) { u32x4 r[4][2];
#pragma unroll
                for (int q = 0; q < 4; ++q) { const int mm = (m + q < m1) ? m + q : m1 - 1; row_raw(X + (size_t)mm * D, F.lane, r[q]); }
#pragma unroll
                for (int q = 0; q < 4; ++q) if (m + q < m1) { f32x4 v[4]; row_unpack(r[q], v); row_ln(v, g, bb, F.lane);
                    if (L + 1 < DEPTH) row_finalize(A, F, m + q, v, L + 1);
                    else {
#pragma unroll
                        for (int j = 0; j < 4; ++j) *(f32x4*)(F.out + O_Y + (size_t)(m + q) * D + RCOL(F.lane, j)) = v[j]; } } }
            if (L + 1 < DEPTH) convert_layer(A, F, L + 1, CV_I);
        }
        SEAM(pb + 10);
    }
#undef IN
#undef SEAM
}

extern "C" void kernel_launch(void* const* d_in, const int* in_sizes, int n_in, void* d_out, int out_size, void* d_ws, size_t ws_size, hipStream_t stream) {
    static int grid = 0;
    if (grid == 0) {
        if (n_in != 28 || (size_t)out_size != O_END || ws_size < WS_END) { fprintf(stderr, "kernel_launch: unexpected shapes: n_in %d out %d ws %zu (need %zu)\n", n_in, out_size, ws_size, (size_t)WS_END); grid = -1; return; }
        int dev = 0, cus = 0, per_cu = 0;
        if (hipGetDevice(&dev) != hipSuccess || hipDeviceGetAttribute(&cus, hipDeviceAttributeMultiprocessorCount, dev) != hipSuccess) { grid = -1; return; }
        if (hipFuncSetAttribute((const void*)fwd, hipFuncAttributeMaxDynamicSharedMemorySize, LDS_BYTES) != hipSuccess) { fprintf(stderr, "kernel_launch: hipFuncSetAttribute failed\n"); grid = -1; return; }
        if (hipOccupancyMaxActiveBlocksPerMultiprocessor(&per_cu, (const void*)fwd, NT, LDS_BYTES) != hipSuccess || per_cu < 1) fprintf(stderr, "kernel_launch: occupancy query says %d\n", per_cu);
        (void)hipGetLastError();
        grid = cus;
    }
    if (grid < 0) return;
    (void)hipMemsetAsync((char*)d_ws + WS_CTL, 0, 128u << 10, stream);
    Args a{};
    for (int i = 0; i < 28; ++i) a.in[i] = (const float*)d_in[i];
    a.out = (float*)d_out; a.ws = (unsigned char*)d_ws;
#if MK_ONE_LAUNCH
    a.ph_lo = 0; a.ph_hi = N_PHASES;
    hipLaunchKernelGGL(fwd, dim3(grid), dim3(NT), LDS_BYTES, stream, a);
#else
    for (int p = 0; p < N_PHASES; ++p) { a.ph_lo = p; a.ph_hi = p + 1; hipLaunchKernelGGL(fwd, dim3(grid), dim3(NT), LDS_BYTES, stream, a); }
#endif
}
```
